# Optimizing an MI355X kernel written in HIP

```python
import math
import jax, jax.numpy as jnp
from jax import lax
import numpy as np

D_MODEL = 1024
BATCH = 16
SEQ = 2048
DEPTH = 4
DEC_BATCH = 8
DEC_SEQ = 64
PAST_LEN = 2048

CHUNK = 64
GM_CHUNK = 128
GM_GROUPS = 4
GM_WIDTH = D_MODEL // 2
GM_HEAD = GM_WIDTH // GM_GROUPS
GLA_HEADS = 4
GLA_KDIM = D_MODEL // 2
GLA_VDIM = D_MODEL
GLA_DK = GLA_KDIM // GLA_HEADS
GLA_DV = GLA_VDIM // GLA_HEADS
GLA_RANK = 16
GLA_TEMP = 16.0
D_FF = 2816
IN_COLS = 2 * GM_WIDTH + 2 * GLA_KDIM + 2 * GLA_VDIM + GLA_RANK + 2 * D_MODEL
ALPHA = (2.0 * DEPTH) ** 0.25
BETA = (8.0 * DEPTH) ** -0.25
EPS = 1e-5

kernel_name = "gmlp_gla_gated_parallel_deepnorm_macaron_stream"


def layer_norm(x, g, b):
    xf = x.astype(jnp.float32)
    mu = jnp.mean(xf, axis=-1, keepdims=True)
    var = jnp.mean(jnp.square(xf - mu), axis=-1, keepdims=True)
    return ((xf - mu) * lax.rsqrt(var + EPS) * g.astype(jnp.float32) + b.astype(jnp.float32)).astype(x.dtype)


def rms_norm(x, g):
    xf = x.astype(jnp.float32)
    return xf * lax.rsqrt(jnp.mean(jnp.square(xf), axis=-1, keepdims=True) + EPS) * g.astype(jnp.float32)


def swiglu(x, w1, w3, w2):
    return (jax.nn.silu(x @ w1) * (x @ w3)) @ w2


def gmlp_spatial(v, ws, bs):
    bn, L, g, dg = v.shape
    c = min(L, GM_CHUNK)
    n = L // c
    mask = jnp.tril(jnp.ones((c, c), dtype=bool))
    w = jnp.where(mask, ws[:, :c, :c], 0.0)
    vc = v.reshape(bn, n, c, g, dg)
    s = jnp.einsum('gts,bnsgd->bntgd', w, vc) + jnp.transpose(bs[:, :c])[None, None, :, :, None]
    return s.reshape(bn, L, g, dg)


def gla_scan(q, k, v, lg, s0, chunk):
    bn, L, h, dk = q.shape
    dv = v.shape[-1]
    n = L // chunk
    mask = jnp.tril(jnp.ones((chunk, chunk), dtype=bool))

    def blocks(a):
        return jnp.moveaxis(a.astype(jnp.float32).reshape(bn, n, chunk, *a.shape[2:]), 1, 0)

    def step(S, xs):
        qc, kc, vc, gc = xs
        b = jnp.cumsum(gc, axis=1)
        qe = qc * jnp.exp(b)
        ke = kc * jnp.exp(-b)
        att = jnp.where(mask, jnp.einsum('bthk,bshk->bhts', qe, ke), 0.0)
        o = jnp.einsum('bhts,bshv->bthv', att, vc) + jnp.einsum('bthk,bhkv->bthv', qe, S)
        bl = b[:, -1]
        S = jnp.exp(bl)[..., None] * S + jnp.einsum('bshk,bshv->bhkv', kc * jnp.exp(bl[:, None] - b), vc)
        return S, o

    S, o = lax.scan(step, s0.astype(jnp.float32), (blocks(q), blocks(k), blocks(v), blocks(lg)))
    return jnp.moveaxis(o, 0, 1).reshape(bn, L, h, dv), S


def mixer(h, w_in, gm_ln_g, gm_ln_b, gm_ws, gm_bs, gla_wa2, gla_ba, gla_norm_g, w_pa, w_pb, w_o, s0):
    bn, L, _ = h.shape
    z = h @ w_in
    sizes = [GM_WIDTH, GM_WIDTH, GLA_KDIM, GLA_KDIM, GLA_VDIM, GLA_VDIM, GLA_RANK, D_MODEL, D_MODEL]
    idx = [int(i) for i in np.cumsum(sizes)[:-1]]
    zu, zv, q, k, vg, gg, glr, ga, gb = jnp.split(z, idx, axis=-1)
    u = jax.nn.gelu(zu, approximate=False)
    vn = layer_norm(jax.nn.gelu(zv, approximate=False), gm_ln_g, gm_ln_b)
    s = gmlp_spatial(vn.reshape(bn, L, GM_GROUPS, GM_HEAD), gm_ws, gm_bs).reshape(bn, L, GM_WIDTH)
    o_a = u * s
    lg = jax.nn.log_sigmoid((glr @ gla_wa2 + gla_ba).astype(jnp.float32)) / GLA_TEMP
    o_b, S = gla_scan(
        q.reshape(bn, L, GLA_HEADS, GLA_DK) * (GLA_DK ** -0.5),
        k.reshape(bn, L, GLA_HEADS, GLA_DK),
        vg.reshape(bn, L, GLA_HEADS, GLA_DV),
        lg.reshape(bn, L, GLA_HEADS, GLA_DK),
        s0, min(L, CHUNK))
    o_b = rms_norm(o_b, gla_norm_g).reshape(bn, L, GLA_VDIM).astype(h.dtype) * jax.nn.silu(gg)
    m = jax.nn.sigmoid(ga) * (o_a @ w_pa) + jax.nn.sigmoid(gb) * (o_b @ w_pb)
    return m @ w_o, S, vn


def setup_inputs(seed: int = 0) -> dict:
    key = jax.random.key(seed)
    ks = jax.random.split(key, 24)
    f32 = jnp.float32

    def nrm(k, shape, scale):
        return jax.random.normal(k, shape, f32) * scale

    return {
        "x_prompt": nrm(ks[0], (BATCH, SEQ, D_MODEL), 1.0),
        "x_sample": nrm(ks[1], (DEC_BATCH, DEC_SEQ, D_MODEL), 1.0),
        "state_gla": nrm(ks[2], (DEPTH, DEC_BATCH, GLA_HEADS, GLA_DK, GLA_DV), 0.3),
        "ln_g": 1.0 + nrm(ks[3], (DEPTH, 3, D_MODEL), 0.02),
        "ln_b": nrm(ks[4], (DEPTH, 3, D_MODEL), 0.02),
        "ffn_w1": nrm(ks[5], (DEPTH, 2, D_MODEL, D_FF), D_MODEL ** -0.5),
        "ffn_w3": nrm(ks[6], (DEPTH, 2, D_MODEL, D_FF), D_MODEL ** -0.5),
        "ffn_w2": nrm(ks[7], (DEPTH, 2, D_FF, D_MODEL), BETA * D_FF ** -0.5),
        "w_in": nrm(ks[8], (DEPTH, D_MODEL, IN_COLS), D_MODEL ** -0.5),
        "gm_ln_g": 1.0 + nrm(ks[9], (DEPTH, GM_WIDTH), 0.02),
        "gm_ln_b": nrm(ks[10], (DEPTH, GM_WIDTH), 0.02),
        "gm_ws": nrm(ks[11], (DEPTH, GM_GROUPS, GM_CHUNK, GM_CHUNK), GM_CHUNK ** -0.5),
        "gm_bs": 1.0 + nrm(ks[12], (DEPTH, GM_GROUPS, GM_CHUNK), 0.02),
        "gla_wa2": nrm(ks[13], (DEPTH, GLA_RANK, GLA_KDIM), GLA_RANK ** -0.5),
        "gla_ba": nrm(ks[14], (DEPTH, GLA_KDIM), 0.1) + 1.0,
        "gla_norm_g": 1.0 + nrm(ks[15], (DEPTH, GLA_DV), 0.02),
        "w_pa": nrm(ks[16], (DEPTH, GM_WIDTH, D_MODEL), GM_WIDTH ** -0.5),
        "w_pb": nrm(ks[17], (DEPTH, GLA_VDIM, D_MODEL), GLA_VDIM ** -0.5),
        "w_o": nrm(ks[18], (DEPTH, D_MODEL, D_MODEL), BETA * D_MODEL ** -0.5),
    }


def layer(x, s0, l, ln_g, ln_b, ffn_w1, ffn_w3, ffn_w2, w_in, gm_ln_g, gm_ln_b, gm_ws, gm_bs,
          gla_wa2, gla_ba, gla_norm_g, w_pa, w_pb, w_o):
    x = layer_norm(ALPHA * x + 0.5 * swiglu(x, ffn_w1[l, 0], ffn_w3[l, 0], ffn_w2[l, 0]), ln_g[l, 0], ln_b[l, 0])
    y, S, vn = mixer(x, w_in[l], gm_ln_g[l], gm_ln_b[l], gm_ws[l], gm_bs[l], gla_wa2[l], gla_ba[l],
                     gla_norm_g[l], w_pa[l], w_pb[l], w_o[l], s0)
    x = layer_norm(ALPHA * x + y, ln_g[l, 1], ln_b[l, 1])
    x = layer_norm(ALPHA * x + 0.5 * swiglu(x, ffn_w1[l, 1], ffn_w3[l, 1], ffn_w2[l, 1]), ln_g[l, 2], ln_b[l, 2])
    return x, S, vn


def reference(x_prompt, x_sample, state_gla, ln_g, ln_b, ffn_w1, ffn_w3, ffn_w2, w_in, gm_ln_g, gm_ln_b,
              gm_ws, gm_bs, gla_wa2, gla_ba, gla_norm_g, w_pa, w_pb, w_o):
    hp = x_prompt
    hs = x_sample
    s_prompt = []
    s_sample = []
    v_sample = []
    s_zero = jnp.zeros((x_prompt.shape[0], GLA_HEADS, GLA_DK, GLA_DV), jnp.float32)
    for l in range(DEPTH):
        hp, Sp, _ = layer(hp, s_zero, l, ln_g, ln_b, ffn_w1, ffn_w3, ffn_w2, w_in, gm_ln_g, gm_ln_b, gm_ws,
                          gm_bs, gla_wa2, gla_ba, gla_norm_g, w_pa, w_pb, w_o)
        hs, Ss, vs = layer(hs, state_gla[l], l, ln_g, ln_b, ffn_w1, ffn_w3, ffn_w2, w_in, gm_ln_g, gm_ln_b,
                           gm_ws, gm_bs, gla_wa2, gla_ba, gla_norm_g, w_pa, w_pb, w_o)
        s_prompt.append(Sp)
        s_sample.append(Ss)
        v_sample.append(vs)
    state_gla_prompt = jnp.stack(s_prompt, axis=0)
    state_gla_sample = jnp.stack(s_sample, axis=0)
    state_gmlp_v_sample = jnp.stack(v_sample, axis=0)
    return (hp, hs, state_gla_prompt, state_gla_sample, state_gmlp_v_sample)
```

```cpp
#include <hip/hip_runtime.h>
#include <hip/hip_cooperative_groups.h>
#include <cstdio>
#include <cstdint>
namespace cg = cooperative_groups;

namespace pg8 {
#define PG8_LAS __attribute__((address_space(3)))
typedef unsigned short bf16_t;
typedef short bf16x8 __attribute__((ext_vector_type(8)));
typedef float f32x4 __attribute__((ext_vector_type(4)));
typedef unsigned u32x4 __attribute__((ext_vector_type(4)));
constexpr int BM = 256, BK = 64, HALF = 128, HTB = HALF * BK * 2  , STAGE_BYTES = 8 * HTB, NXCD = 8, WGM = 8;

__host__ __device__ __forceinline__ int lds_byte(int r, int c) { const int st = (r >> 4) * 2 + (c >> 5), rr = r & 15, cc = c & 31, ob = rr * 64 + cc * 2; return st * 1024 + (ob ^ (((ob >> 9) & 1) << 5)); }
__host__ __device__ __forceinline__ void stage_rc(int b, int& R, int& C) { const int st = b / 1024, sb = b % 1024, swz = sb ^ (((sb >> 9) & 1) << 5); R = (st >> 1) * 16 + swz / 64; C = (st & 1) * 32 + (swz % 64) / 2; }
__host__ __device__ __forceinline__ int perm32(int rho) { const int n = rho >> 4, i = rho & 15; return 8 * (i >> 2) + 4 * n + (i & 3); }

struct Unit { int pm, pn; };
struct Gemm { const bf16_t* A; const bf16_t* Bt; int lda, M, N, K; };

struct StaticOrder {
    int nM, nN, nwg, G, c;
    __host__ __device__ void init(int M, int N, int G_, int c_) { nM = M / BM; nN = N / BM; nwg = nM * nN; G = G_; c = c_; }
    __host__ __device__ bool next(int i, Unit& u) const {
        const long L = (long)i * G + c; if (L >= nwg) return false;
        int wgid = (int)L; { const int q = nwg / NXCD, r = nwg % NXCD, xcd = wgid % NXCD, off = wgid / NXCD; wgid = (xcd < r ? xcd * (q + 1) : r * (q + 1) + (xcd - r) * q) + off; }
        const int nig = WGM * nN, gid = wgid / nig, fm = gid * WGM, gsz = (nM - fm) < WGM ? (nM - fm) : WGM;
        u.pm = fm + ((wgid % nig) % gsz); u.pn = (wgid % nig) / gsz; return true;
    }
    __device__ __forceinline__ void a_ready(const Unit&) const {}
    __device__ __forceinline__ void done(const Unit&) const {}
};
__device__ __forceinline__ unsigned cvt_pk_bf16(float lo, float hi) { unsigned r; asm volatile("v_cvt_pk_bf16_f32 %0, %1, %2" : "=v"(r) : "v"(lo), "v"(hi)); return r; }
typedef float f32x2 __attribute__((ext_vector_type(2)));
__device__ __forceinline__ f32x2 gelu_pk(f32x2 v) {
    const f32x2 av = __builtin_elementwise_abs(v), d = av * 0.2316418882f + 1.0f;
    f32x2 t; t.x = __builtin_amdgcn_rcpf(d.x); t.y = __builtin_amdgcn_rcpf(d.y);
    f32x2 q = t * 0.5307027145f + (-0.7265760135f); q = q * t + 0.7107068705f; q = q * t + (-0.142248368f); q = q * t + 0.127414796f; q = q * t;
    const f32x2 s = (v * v) * (-0.72134752044f);
    f32x2 e; e.x = __builtin_amdgcn_exp2f(s.x); e.y = __builtin_amdgcn_exp2f(s.y);
    const f32x2 m = v * (q * e), r = v - m;
    f32x2 o; o.x = v.x < 0.f ? m.x : r.x; o.y = v.y < 0.f ? m.y : r.y; return o;
}

template <class Epi, class Sched, bool ALIGN_EPI = false, bool SP2 = false>
__device__ __forceinline__ void gemm_phase(PG8_LAS unsigned char* lds, const Gemm g, const Sched& S, const Epi& E) {
    int tid = threadIdx.x; asm volatile("" : "+v"(tid));
    const int wid = __builtin_amdgcn_readfirstlane(tid >> 6), lane = tid & 63, wr = wid >> 2, wc = wid & 3, fr = lane & 15, fq = lane >> 4;
    const int K = g.K, nt = K / BK;
    unsigned voffA[2], voffB[2];
#pragma unroll
    for (int i = 0; i < 2; ++i) { int R, C; stage_rc(tid * 16 + i * 8192, R, C); const int Rb = Epi::PERM ? ((R & ~31) + perm32(R & 31)) : R;
        voffA[i] = (unsigned)(R * g.lda + C) * 2u; voffB[i] = (unsigned)(Rb * K + C) * 2u; }
    const size_t kstep = (size_t)(BK * 2);
    const size_t hstepA = (size_t)HALF * g.lda * 2, hstepB = (size_t)HALF * K * 2;
    const size_t tstepA = 2 * hstepA, tstepB = 2 * hstepB;
    const unsigned ldsw = (unsigned)wid * 1024u;
    const int aoff = lds_byte(wr * 64 + fr, fq * 8), boff = lds_byte(wc * 32 + fr, fq * 8);
#define PG8_SA(b, h) (((b) * 2 + (h)) * HTB)
#define PG8_SB(b, h) ((4 + (b) * 2 + (h)) * HTB)
#define PG8_STAGE(bufoff, gbase, voff) do { _Pragma("unroll") for (int _i = 0; _i < 2; ++_i) \
        __builtin_amdgcn_global_load_lds((const unsigned*)((const char*)(gbase) + (voff)[_i]), (PG8_LAS unsigned*)(lds + (bufoff) + ldsw + _i * 8192), 16, 0, 0); } while (0)
#define PG8_LDA(dst, b, h) do { _Pragma("unroll") for (int m = 0; m < 4; ++m) _Pragma("unroll") for (int k = 0; k < 2; ++k) dst[m][k] = *(const PG8_LAS bf16x8*)(lds + PG8_SA(b, h) + aoff + m * 2048 + k * 1024); } while (0)
#define PG8_LDB(dst, b, h) do { _Pragma("unroll") for (int n = 0; n < 2; ++n) _Pragma("unroll") for (int k = 0; k < 2; ++k) dst[n][k] = *(const PG8_LAS bf16x8*)(lds + PG8_SB(b, h) + boff + n * 2048 + k * 1024); } while (0)
#define PG8_MMA(ai, bj, At, Bt) do { __builtin_amdgcn_s_setprio(1); _Pragma("unroll") for (int m = 0; m < 4; ++m) _Pragma("unroll") for (int n = 0; n < 2; ++n) _Pragma("unroll") for (int k = 0; k < 2; ++k) \
        acc[ai][bj][m][n] = __builtin_amdgcn_mfma_f32_16x16x32_bf16(Bt[n][k], At[m][k], acc[ai][bj][m][n], 0, 0, 0); __builtin_amdgcn_s_setprio(0); } while (0)
#define PG8_WAIT_V(n) asm volatile("s_waitcnt vmcnt(" #n ")" ::: "memory")
#define PG8_WAIT_L(n) asm volatile("s_waitcnt lgkmcnt(" #n ")" ::: "memory")
#define PG8_BAR __builtin_amdgcn_s_barrier()
#define PG8_SCHED __builtin_amdgcn_sched_barrier(0)
    Unit cur, nxt; int ui = 0;
    if (!S.next(0, cur)) return;
    f32x4 acc[2][2][4][2];
#pragma unroll
    for (int a = 0; a < 2; ++a)
#pragma unroll
        for (int b = 0; b < 2; ++b)
#pragma unroll
            for (int m = 0; m < 4; ++m)
#pragma unroll
                for (int n = 0; n < 2; ++n) acc[a][b][m][n] = (f32x4){0.f, 0.f, 0.f, 0.f};
    bf16x8 At[4][2], B0[2][2], B1[2][2];
    const char* cA = (const char*)g.A + (size_t)cur.pm * tstepA; const char* cB = (const char*)g.Bt + (size_t)cur.pn * tstepB;
    S.a_ready(cur);
    if constexpr (SP2) {
        PG8_STAGE(PG8_SB(0, 0), cB, voffB); PG8_STAGE(PG8_SB(0, 1), cB + hstepB, voffB); PG8_STAGE(PG8_SA(0, 0), cA, voffA); PG8_STAGE(PG8_SA(0, 1), cA + hstepA, voffA);
        if (wr == 1) PG8_BAR;
        PG8_WAIT_V(2); PG8_BAR;
        PG8_STAGE(PG8_SB(1, 0), cB + kstep, voffB); PG8_STAGE(PG8_SA(1, 0), cA + kstep, voffA); PG8_STAGE(PG8_SB(1, 1), cB + hstepB + kstep, voffB);
        PG8_WAIT_V(6); PG8_BAR;
    } else {
        PG8_STAGE(PG8_SB(0, 0), cB, voffB); PG8_STAGE(PG8_SA(0, 0), cA, voffA); PG8_STAGE(PG8_SB(0, 1), cB + hstepB, voffB); PG8_STAGE(PG8_SA(0, 1), cA + hstepA, voffA);
        if (wr == 1) PG8_BAR;
        PG8_WAIT_V(4); PG8_BAR;
        PG8_STAGE(PG8_SB(1, 0), cB + kstep, voffB); PG8_STAGE(PG8_SA(1, 0), cA + kstep, voffA); PG8_STAGE(PG8_SB(1, 1), cB + hstepB + kstep, voffB);
        PG8_WAIT_V(6); PG8_BAR;
    }
    for (;;) {
        const bool has_next = S.next(ui + 1, nxt);
        const char* nA = has_next ? (const char*)g.A + (size_t)nxt.pm * tstepA : cA; const char* nB = has_next ? (const char*)g.Bt + (size_t)nxt.pn * tstepB : cB;
        for (int t = 0; t < nt; t += 2) {
            const bool last = (t == nt - 2);
            const char* a1 = cA + (size_t)(t + 1) * kstep;
            const char* a2 = last ? nA : cA + (size_t)(t + 2) * kstep; const char* b2 = last ? nB : cB + (size_t)(t + 2) * kstep;
            const char* a3 = a2 + kstep; const char* b3 = b2 + kstep;
            if (last && has_next) S.a_ready(nxt);
            if constexpr (SP2) {
            PG8_LDB(B0, 0, 0); PG8_LDB(B1, 0, 1); PG8_SCHED; PG8_LDA(At, 0, 0); PG8_STAGE(PG8_SA(1, 1), a1 + hstepA, voffA);
            PG8_WAIT_V(8); PG8_WAIT_L(0); PG8_BAR; PG8_MMA(0, 0, At, B0); PG8_MMA(0, 1, At, B1); PG8_BAR; PG8_SCHED;
            PG8_LDA(At, 0, 1); PG8_STAGE(PG8_SB(0, 0), b2, voffB); PG8_STAGE(PG8_SB(0, 1), b2 + hstepB, voffB); PG8_STAGE(PG8_SA(0, 0), a2, voffA);
            PG8_WAIT_V(8); PG8_WAIT_L(0); PG8_BAR; PG8_MMA(1, 0, At, B0); PG8_MMA(1, 1, At, B1); PG8_BAR; PG8_SCHED;
            PG8_LDB(B0, 1, 0); PG8_LDB(B1, 1, 1); PG8_SCHED; PG8_LDA(At, 1, 0); PG8_STAGE(PG8_SA(0, 1), a2 + hstepA, voffA);
            PG8_WAIT_V(8); PG8_WAIT_L(0); PG8_BAR; PG8_MMA(0, 0, At, B0); PG8_MMA(0, 1, At, B1); PG8_BAR; PG8_SCHED;
            PG8_LDA(At, 1, 1); PG8_STAGE(PG8_SB(1, 0), b3, voffB); PG8_STAGE(PG8_SB(1, 1), b3 + hstepB, voffB); PG8_STAGE(PG8_SA(1, 0), a3, voffA);
            PG8_WAIT_V(8); PG8_WAIT_L(0); PG8_BAR; PG8_MMA(1, 0, At, B0); PG8_MMA(1, 1, At, B1); PG8_BAR; PG8_SCHED;
            } else {
            PG8_LDB(B0, 0, 0); PG8_SCHED; PG8_LDA(At, 0, 0); PG8_STAGE(PG8_SA(1, 1), a1 + hstepA, voffA);
            PG8_WAIT_L(8); PG8_BAR; PG8_WAIT_L(0); PG8_MMA(0, 0, At, B0); PG8_BAR; PG8_SCHED;
            PG8_LDB(B1, 0, 1); PG8_STAGE(PG8_SB(0, 0), b2, voffB);
            PG8_BAR; PG8_WAIT_L(0); PG8_MMA(0, 1, At, B1); PG8_BAR;
            PG8_LDA(At, 0, 1); PG8_STAGE(PG8_SA(0, 0), a2, voffA);
            PG8_BAR; PG8_WAIT_L(0); PG8_MMA(1, 0, At, B0); PG8_BAR; PG8_SCHED;
            PG8_STAGE(PG8_SB(0, 1), b2 + hstepB, voffB);
            PG8_WAIT_V(6); PG8_BAR; PG8_MMA(1, 1, At, B1); PG8_BAR;
            PG8_LDB(B0, 1, 0); PG8_SCHED; PG8_LDA(At, 1, 0); PG8_STAGE(PG8_SA(0, 1), a2 + hstepA, voffA);
            PG8_WAIT_L(8); PG8_BAR; PG8_WAIT_L(0); PG8_MMA(0, 0, At, B0); PG8_BAR; PG8_SCHED;
            PG8_LDB(B1, 1, 1); PG8_STAGE(PG8_SB(1, 0), b3, voffB);
            PG8_BAR; PG8_WAIT_L(0); PG8_MMA(0, 1, At, B1); PG8_BAR;
            PG8_LDA(At, 1, 1); PG8_STAGE(PG8_SA(1, 0), a3, voffA);
            PG8_BAR; PG8_WAIT_L(0); PG8_MMA(1, 0, At, B0); PG8_BAR; PG8_SCHED;
            PG8_STAGE(PG8_SB(1, 1), b3 + hstepB, voffB);
            PG8_WAIT_V(6); PG8_BAR; PG8_MMA(1, 1, At, B1); PG8_BAR;
            }
        }
        if constexpr (ALIGN_EPI) { if (wr == 0) PG8_BAR; }
        if constexpr (!Epi::AFTER_DRAIN) { E(acc, cur, wr, wc, fr, fq); S.done(cur); }
        if (!has_next) break;
#pragma unroll
        for (int a = 0; a < 2; ++a)
#pragma unroll
            for (int b = 0; b < 2; ++b)
#pragma unroll
                for (int m = 0; m < 4; ++m)
#pragma unroll
                    for (int n = 0; n < 2; ++n) acc[a][b][m][n] = (f32x4){0.f, 0.f, 0.f, 0.f};
        cur = nxt; cA = nA; cB = nB; ++ui;
        if constexpr (ALIGN_EPI) { if (wr == 1) PG8_BAR; }
    }
    PG8_WAIT_V(0);
    if constexpr (!ALIGN_EPI) { if (wr == 0) PG8_BAR; }
    PG8_BAR;
    if constexpr (Epi::AFTER_DRAIN) { E.fused(acc, cur, wr, wc, fr, fq, lds, wid, lane); S.done(cur); }
#undef PG8_SA
#undef PG8_SB
#undef PG8_STAGE
#undef PG8_LDA
#undef PG8_LDB
#undef PG8_MMA
#undef PG8_WAIT_V
#undef PG8_WAIT_L
#undef PG8_BAR
#undef PG8_SCHED
}
}

#define LAS __attribute__((address_space(3)))
typedef unsigned short bf16;
typedef pg8::f32x4 f32x4;
typedef pg8::f32x2 f32x2;
typedef pg8::u32x4 u32x4;
typedef pg8::bf16x8 bf16x8;
typedef unsigned u32x2 __attribute__((ext_vector_type(2)));
constexpr int DM = 1024, NBATCH = 16, SEQ = 2048, DEPTH = 4, DBATCH = 8, DSEQ = 64;
constexpr int MP = NBATCH * SEQ, MS = DBATCH * DSEQ, MT = MP + MS;
constexpr int DFF = 2816, NUP = 2 * DFF, INC = 6160, NIN = 6400, ZW = 6144;
constexpr int ZU = 0, ZV = 512, ZQ = 1024, ZK = 1536, ZVG = 2048, ZGG = 3072, ZGA = 4096, ZGB = 5120;
constexpr int NCHUNK = MT / 64;
constexpr float ALPHA = 1.6817928305074290f, LN_EPS = 1e-5f;
constexpr size_t STAT_BYTES = (size_t)MT * 2 * 8;
constexpr size_t WS_STATS = 0;
constexpr size_t WS_GST = WS_STATS + 13 * STAT_BYTES;
constexpr int CSCB_L = 2 * (NUP + NIN + NUP);
constexpr size_t WS_CSCB = WS_GST + 4 * STAT_BYTES;
constexpr size_t ZERO_BYTES = 10u << 20;
static_assert(WS_CSCB + (size_t)DEPTH * CSCB_L * 8 <= ZERO_BYTES, "zero region");
constexpr size_t WS_ONES = ZERO_BYTES;
constexpr size_t WS_W13A = WS_ONES + 65536;
constexpr size_t WS_W2A = WS_W13A + (size_t)NUP * DM * 2;
constexpr size_t WS_WIN = WS_W2A + (size_t)DM * DFF * 2;
constexpr size_t WS_WPA = WS_WIN + (size_t)NIN * DM * 2;
constexpr size_t WS_WPB = WS_WPA + (size_t)DM * 512 * 2;
constexpr size_t WS_WO = WS_WPB + (size_t)DM * DM * 2;
constexpr size_t WS_W13B = WS_WO + (size_t)DM * DM * 2;
constexpr size_t WS_W2B = WS_W13B + (size_t)NUP * DM * 2;
constexpr size_t WS_WSB = WS_W2B + (size_t)DM * DFF * 2;
constexpr size_t WS_GLR = WS_WSB + 4 * 128 * 128 * 2;
constexpr size_t WS_DEC = WS_GLR + (size_t)MT * 16 * 4;
constexpr size_t WS_VB = WS_DEC + (size_t)NCHUNK * 512 * 4;
constexpr size_t WS_Z = WS_VB + (size_t)MT * DM * 2;
constexpr size_t WS_END = WS_Z + (size_t)MT * ZW * 2;
constexpr size_t OUT_SP = (size_t)MT * DM, OUT_SS = OUT_SP + (size_t)DEPTH * NBATCH * 4 * 128 * 256, OUT_VN = OUT_SS + (size_t)DEPTH * DBATCH * 4 * 128 * 256;
constexpr size_t OUT_END = OUT_VN + (size_t)DEPTH * DBATCH * DSEQ * 512;
constexpr int LDS_BYTES = 147456;

struct Params { const float* in[19]; float* out; unsigned char* ws; };
enum { I_XP = 0, I_XS, I_STATE, I_LNG, I_LNB, I_W1, I_W3, I_W2, I_WIN, I_GMG, I_GMB, I_GMWS, I_GMBS, I_WA2, I_BA, I_GNG, I_WPA, I_WPB, I_WO };

__device__ __forceinline__ unsigned f2bf(float f) { unsigned u = __float_as_uint(f); return (u + 0x7fffu + ((u >> 16) & 1u)) >> 16; }
__device__ __forceinline__ float bf2f(unsigned h) { return __uint_as_float(h << 16); }
__device__ __forceinline__ float bflo(unsigned w) { return __uint_as_float(w << 16); }
__device__ __forceinline__ float bfhi(unsigned w) { return __uint_as_float(w & 0xffff0000u); }
__device__ __forceinline__ unsigned pk2(float lo, float hi) { return pg8::cvt_pk_bf16(lo, hi); }
__device__ __forceinline__ float sigmoidf_(float x) { return __builtin_amdgcn_rcpf(1.0f + __expf(-x)); }
typedef long long i64;
typedef long long i64x2 __attribute__((ext_vector_type(2)));
constexpr float FXS = 1048576.0f, FXS_INV = 1.0f / 1048576.0f;
constexpr float FXC = 4294967296.0f, FXC_INV = 1.0f / 4294967296.0f;
__device__ __forceinline__ void fx_add(i64* p, float v, float scale) { atomicAdd((unsigned long long*)p, (unsigned long long)(i64)(v * scale)); }
__device__ __forceinline__ f32x4 ld_fx4(const i64* p) { const i64x2 a = *(const i64x2*)p, b = *(const i64x2*)(p + 2); return (f32x4){(float)a.x, (float)a.y, (float)b.x, (float)b.y} * FXC_INV; }
__device__ __forceinline__ void row_stat(const i64* st, int r, float& mu, float& rstd) {
    const i64x2 s = *(const i64x2*)(st + 2 * (size_t)r); mu = (float)s.x * (FXS_INV / DM); const float var = fmaxf((float)s.y * (FXS_INV / DM) - mu * mu, 0.f); rstd = rsqrtf(var + LN_EPS);
}
#define LDS_WAIT() asm volatile("s_waitcnt lgkmcnt(0)" ::: "memory")

struct EpiUp {
    static constexpr bool PERM = true, AFTER_DRAIN = false;
    bf16* H; const i64* st; const i64* cs; const i64* cb;
    __device__ __forceinline__ void operator()(const f32x4 (&acc)[2][2][4][2], const pg8::Unit& u, int wr, int wc, int fr, int fq) const {
        const int row0 = u.pm * 256 + wr * 64 + fr, cidx = u.pn * 256 + wc * 32 + 8 * fq, hcol = u.pn * 128 + wc * 32 + 8 * fq;
#pragma unroll
        for (int n = 0; n < 2; ++n) {
            const f32x4 s1 = ld_fx4(cs + cidx + 4 * n), s3 = ld_fx4(cs + cidx + 128 + 4 * n), b1 = ld_fx4(cb + cidx + 4 * n), b3 = ld_fx4(cb + cidx + 128 + 4 * n);
#pragma unroll
            for (int ai = 0; ai < 2; ++ai)
#pragma unroll
                for (int m = 0; m < 4; ++m) {
                    const int r = row0 + ai * 128 + m * 16; float mu, rstd; row_stat(st, r, mu, rstd);
                    const f32x4 a1 = (acc[ai][0][m][n] - mu * s1) * rstd + b1, a3 = (acc[ai][1][m][n] - mu * s3) * rstd + b3;
                    f32x4 h;
#pragma unroll
                    for (int j = 0; j < 4; ++j) h[j] = a1[j] * sigmoidf_(a1[j]) * a3[j];
                    u32x2 w; w.x = pk2(h[0], h[1]); w.y = pk2(h[2], h[3]);
                    *(u32x2*)(H + (size_t)r * DFF + hcol + 4 * n) = w;
                    if (m & 1) asm volatile("" ::: "memory");
                }
        }
    }
};
struct EpiZ {
    static constexpr bool PERM = true, AFTER_DRAIN = false;
    bf16* Z; const i64* st; const i64* cs; const i64* cb; i64* gst; float* glr;
    __device__ __forceinline__ void operator()(const f32x4 (&acc)[2][2][4][2], const pg8::Unit& u, int wr, int wc, int fr, int fq) const {
        const int row0 = u.pm * 256 + wr * 64 + fr, col0 = u.pn * 256 + wc * 32 + 8 * fq, pn = u.pn;
        const int kind = pn < 4 ? 0 : pn < 12 ? 1 : pn < 16 ? 2 : pn < 24 ? 3 : 4;
        f32x4 sv[2][2], bv[2][2];
#pragma unroll
        for (int bj = 0; bj < 2; ++bj)
#pragma unroll
            for (int n = 0; n < 2; ++n) { sv[bj][n] = ld_fx4(cs + col0 + bj * 128 + 4 * n); bv[bj][n] = ld_fx4(cb + col0 + bj * 128 + 4 * n); }
#pragma unroll
        for (int ai = 0; ai < 2; ++ai)
#pragma unroll
            for (int m = 0; m < 4; ++m) {
                const int r = row0 + ai * 128 + m * 16; float mu, rstd; row_stat(st, r, mu, rstd);
                float s = 0.f, ss = 0.f;
#pragma unroll
                for (int bj = 0; bj < 2; ++bj) {
                    f32x4 v[2];
#pragma unroll
                    for (int n = 0; n < 2; ++n) {
                        v[n] = (acc[ai][bj][m][n] - mu * sv[bj][n]) * rstd + bv[bj][n];
                        if (kind == 0) { const f32x2 a = pg8::gelu_pk((f32x2){v[n][0], v[n][1]}), b = pg8::gelu_pk((f32x2){v[n][2], v[n][3]}); v[n] = (f32x4){a.x, a.y, b.x, b.y}; }
                        else if (kind == 2) {
#pragma unroll
                            for (int j = 0; j < 4; ++j) v[n][j] = v[n][j] * sigmoidf_(v[n][j]); }
                        else if (kind == 3) {
#pragma unroll
                            for (int j = 0; j < 4; ++j) v[n][j] = sigmoidf_(v[n][j]); }
                        s += (v[n][0] + v[n][1]) + (v[n][2] + v[n][3]); ss += (v[n][0] * v[n][0] + v[n][1] * v[n][1]) + (v[n][2] * v[n][2] + v[n][3] * v[n][3]);
                    }
                    if (kind != 4) { u32x4 w; w.x = pk2(v[0][0], v[0][1]); w.y = pk2(v[0][2], v[0][3]); w.z = pk2(v[1][0], v[1][1]); w.w = pk2(v[1][2], v[1][3]);
                        *(u32x4*)(Z + (size_t)r * ZW + col0 + bj * 128) = w; }
                    else if (bj == 0 && wc == 0 && fq < 2) { *(f32x4*)(glr + (size_t)r * 16 + 8 * fq) = v[0]; *(f32x4*)(glr + (size_t)r * 16 + 8 * fq + 4) = v[1]; }
                }
                if (pn == 2 || pn == 3) { s += __shfl_xor(s, 16); s += __shfl_xor(s, 32); ss += __shfl_xor(ss, 16); ss += __shfl_xor(ss, 32);
                    if (fq == 0) { fx_add(gst + 2 * (size_t)r, s, FXS); fx_add(gst + 2 * (size_t)r + 1, ss, FXS); } }
                asm volatile("" ::: "memory");
            }
    }
};
struct EpiRes {
    static constexpr bool PERM = true, AFTER_DRAIN = false;
    float* V; bf16* VB; const i64* st_in; const float* g_in; const float* b_in; i64* st_out; float ascale;
    __device__ __forceinline__ void operator()(const f32x4 (&acc)[2][2][4][2], const pg8::Unit& u, int wr, int wc, int fr, int fq) const {
        const int row0 = u.pm * 256 + wr * 64 + fr, col0 = u.pn * 256 + wc * 32 + 8 * fq;
        f32x4 gv[2][2], bv[2][2];
#pragma unroll
        for (int bj = 0; bj < 2; ++bj)
#pragma unroll
            for (int n = 0; n < 2; ++n) { gv[bj][n] = *(const f32x4*)(g_in + col0 + bj * 128 + 4 * n); bv[bj][n] = *(const f32x4*)(b_in + col0 + bj * 128 + 4 * n); }
#pragma unroll
        for (int ai = 0; ai < 2; ++ai)
#pragma unroll
            for (int m = 0; m < 4; ++m) {
                const int r = row0 + ai * 128 + m * 16; float mu, rstd; row_stat(st_in, r, mu, rstd);
                float s = 0.f, ss = 0.f; float* vp = V + (size_t)r * DM + col0; bf16* vbp = VB + (size_t)r * DM + col0;
#pragma unroll
                for (int bj = 0; bj < 2; ++bj) {
                    f32x4 o[2];
#pragma unroll
                    for (int n = 0; n < 2; ++n) {
                        const f32x4 vin = *(const f32x4*)(vp + bj * 128 + 4 * n);
                        const f32x4 x = (vin - mu) * rstd * gv[bj][n] + bv[bj][n];
                        o[n] = x * ALPHA + acc[ai][bj][m][n] * ascale;
                        *(f32x4*)(vp + bj * 128 + 4 * n) = o[n];
                        s += (o[n][0] + o[n][1]) + (o[n][2] + o[n][3]); ss += (o[n][0] * o[n][0] + o[n][1] * o[n][1]) + (o[n][2] * o[n][2] + o[n][3] * o[n][3]);
                    }
                    u32x4 w; w.x = pk2(o[0][0], o[0][1]); w.y = pk2(o[0][2], o[0][3]); w.z = pk2(o[1][0], o[1][1]); w.w = pk2(o[1][2], o[1][3]);
                    *(u32x4*)(vbp + bj * 128) = w;
                }
                s += __shfl_xor(s, 16); s += __shfl_xor(s, 32); ss += __shfl_xor(ss, 16); ss += __shfl_xor(ss, 32);
                if (fq == 0) { fx_add(st_out + 2 * (size_t)r, s, FXS); fx_add(st_out + 2 * (size_t)r + 1, ss, FXS); }
                asm volatile("" ::: "memory");
            }
    }
};
template <bool SECOND> struct EpiGate {
    static constexpr bool PERM = true, AFTER_DRAIN = false;
    bf16* Z;
    __device__ __forceinline__ void operator()(const f32x4 (&acc)[2][2][4][2], const pg8::Unit& u, int wr, int wc, int fr, int fq) const {
        const int row0 = u.pm * 256 + wr * 64 + fr, col0 = u.pn * 256 + wc * 32 + 8 * fq;
#pragma unroll
        for (int ai = 0; ai < 2; ++ai)
#pragma unroll
            for (int m = 0; m < 4; ++m) {
                bf16* zr = Z + (size_t)(row0 + ai * 128 + m * 16) * ZW + col0;
#pragma unroll
                for (int bj = 0; bj < 2; ++bj) {
                    bf16* pg = zr + (SECOND ? ZGB : ZGA) + bj * 128;
                    const u32x4 g = *(const u32x4*)pg; u32x4 t = (u32x4){0u, 0u, 0u, 0u};
                    if (SECOND) t = *(const u32x4*)(zr + ZGA + bj * 128);
                    const f32x4 a0 = acc[ai][bj][m][0], a1 = acc[ai][bj][m][1];
                    u32x4 w;
                    w.x = pk2(bflo(t.x) + bflo(g.x) * a0[0], bfhi(t.x) + bfhi(g.x) * a0[1]);
                    w.y = pk2(bflo(t.y) + bflo(g.y) * a0[2], bfhi(t.y) + bfhi(g.y) * a0[3]);
                    w.z = pk2(bflo(t.z) + bflo(g.z) * a1[0], bfhi(t.z) + bfhi(g.z) * a1[1]);
                    w.w = pk2(bflo(t.w) + bflo(g.w) * a1[2], bfhi(t.w) + bfhi(g.w) * a1[3]);
                    *(u32x4*)pg = w;
                }
                asm volatile("" ::: "memory");
            }
    }
};

__device__ __forceinline__ void conv_item(const float* W, int ldw, int src_c0, int nvalid, int k0, bf16* WT, int K, int dst_n0,
                                          const float* g, const float* b, float scale, i64* cs, i64* cb, LAS float* scr, int lane) {
    const int n = lane & 31, hh = lane >> 5;
    float sc = 0.f, sb = 0.f;
#pragma unroll 8
    for (int i = 0; i < 32; ++i) { const int kk = 2 * i + hh;
        const float w = (n < nvalid) ? W[(size_t)(k0 + kk) * ldw + src_c0 + n] * scale : 0.f;
        const float gk = g ? g[k0 + kk] : 1.f, bk = b ? b[k0 + kk] : 0.f;
        const float wf = bf2f(f2bf(w * gk));
        scr[kk * 33 + n] = wf; sc += wf; sb += w * bk; }
    if (cs) { sc += __shfl_xor(sc, 32); sb += __shfl_xor(sb, 32); if (lane < 32) { fx_add(cs + dst_n0 + n, sc, FXC); fx_add(cb + dst_n0 + n, sb, FXC); } }
    LDS_WAIT();
    const int c = lane & 7;
#pragma unroll
    for (int j = 0; j < 4; ++j) { const int nn = (lane >> 3) + 8 * j; const LAS float* s = scr + (8 * c) * 33 + nn;
        u32x4 o;
        o.x = (__float_as_uint(s[0 * 33]) >> 16) | (__float_as_uint(s[1 * 33]) & 0xffff0000u); o.y = (__float_as_uint(s[2 * 33]) >> 16) | (__float_as_uint(s[3 * 33]) & 0xffff0000u);
        o.z = (__float_as_uint(s[4 * 33]) >> 16) | (__float_as_uint(s[5 * 33]) & 0xffff0000u); o.w = (__float_as_uint(s[6 * 33]) >> 16) | (__float_as_uint(s[7 * 33]) & 0xffff0000u);
        *(u32x4*)(WT + (size_t)(dst_n0 + nn) * K + k0 + 8 * c) = o; }
    LDS_WAIT();
}
__device__ __forceinline__ void convert_phase(const Params& P, int l, LAS unsigned char* lds) {
    int tid = threadIdx.x; asm volatile("" : "+v"(tid));
    const int lane = tid & 63, wave = tid >> 6, G = gridDim.x;
    LAS float* scr = (LAS float*)(lds + wave * 16384);
    unsigned char* ws = P.ws;
    const float* lng = P.in[I_LNG]; const float* lnb = P.in[I_LNB];
    i64* cscb = (i64*)(ws + WS_CSCB) + (size_t)l * CSCB_L;
    i64 *cs13a = cscb, *cb13a = cscb + NUP, *csin = cscb + 2 * NUP, *cbin = csin + NIN, *cs13b = cbin + NIN, *cb13b = cs13b + NUP;
    const int gw = blockIdx.x * 8 + wave, NGW = G * 8;
    constexpr int I_UP = 16 * 88, I_DN = 44 * 32, I_IN = 16 * 200, I_PA = 8 * 32, I_PB = 16 * 32;
    constexpr int NITEMS = 4 * I_UP + 2 * I_DN + I_IN + I_PA + 2 * I_PB;
    for (int it = gw; it < NITEMS; it += NGW) {
        int r = it;
        if (r < 4 * I_UP) {
            const int sub = r / I_UP; r -= sub * I_UP; const int kb = r / 88, nb = r % 88, which = sub >> 1;
            const float* W = P.in[(sub & 1) ? I_W3 : I_W1] + (size_t)(l * 2 + which) * DM * DFF;
            const int c0 = nb * 32, dst = (c0 >> 7) * 256 + (sub & 1) * 128 + (c0 & 127);
            const float *g = nullptr, *b = nullptr;
            if (which == 1) { g = lng + (l * 3 + 1) * DM; b = lnb + (l * 3 + 1) * DM; } else if (l > 0) { g = lng + ((l - 1) * 3 + 2) * DM; b = lnb + ((l - 1) * 3 + 2) * DM; }
            conv_item(W, DFF, c0, 32, kb * 64, (bf16*)(ws + (which ? WS_W13B : WS_W13A)), DM, dst, g, b, 1.f, which ? cs13b : cs13a, which ? cb13b : cb13a, scr, lane);
            continue; }
        r -= 4 * I_UP;
        if (r < 2 * I_DN) { const int which = r / I_DN; r -= which * I_DN; const int kb = r / 32, nb = r % 32;
            conv_item(P.in[I_W2] + (size_t)(l * 2 + which) * DFF * DM, DM, nb * 32, 32, kb * 64, (bf16*)(ws + (which ? WS_W2B : WS_W2A)), DFF, nb * 32, nullptr, nullptr, 1.f, nullptr, nullptr, scr, lane);
            continue; }
        r -= 2 * I_DN;
        if (r < I_IN) { const int kb = r / 200, nb = r % 200, dst = nb * 32;
            int src = dst, nv = 32; float scale = 1.f;
            if (dst >= 4096 && dst < 6144) src = dst + 16; else if (dst == 6144) { src = 4096; nv = 16; } else if (dst > 6144) { src = 0; nv = 0; }
            if (dst >= ZQ && dst < ZK) scale = 0.08838834764831845f;
            conv_item(P.in[I_WIN] + (size_t)l * DM * INC, INC, src, nv, kb * 64, (bf16*)(ws + WS_WIN), DM, dst, lng + (l * 3) * DM, lnb + (l * 3) * DM, scale, csin, cbin, scr, lane);
            continue; }
        r -= I_IN;
        if (r < I_PA) { const int kb = r / 32, nb = r % 32;
            conv_item(P.in[I_WPA] + (size_t)l * 512 * DM, DM, nb * 32, 32, kb * 64, (bf16*)(ws + WS_WPA), 512, nb * 32, nullptr, nullptr, 1.f, nullptr, nullptr, scr, lane); continue; }
        r -= I_PA;
        { const int which = r / I_PB; r -= which * I_PB; const int kb = r / 32, nb = r % 32;
            conv_item(P.in[which ? I_WO : I_WPB] + (size_t)l * DM * DM, DM, nb * 32, 32, kb * 64, (bf16*)(ws + (which ? WS_WO : WS_WPB)), DM, nb * 32, nullptr, nullptr, 1.f, nullptr, nullptr, scr, lane); }
    }
    { const float* wsrc = P.in[I_GMWS] + (size_t)l * 65536; bf16* wd = (bf16*)(ws + WS_WSB);
      for (int i = blockIdx.x * 512 + tid; i < 65536; i += G * 512) { const int t = (i >> 7) & 127, s = i & 127; wd[i] = (bf16)(t >= s ? f2bf(wsrc[i]) : 0u); } }
    if (l == 0) {
        float* V = P.out; bf16* VB = (bf16*)(ws + WS_VB); i64* st0 = (i64*)(ws + WS_STATS);
        for (int m = gw; m < MT; m += NGW) {
            const float* xr = (m < MP) ? P.in[I_XP] + (size_t)m * DM : P.in[I_XS] + (size_t)(m - MP) * DM;
#pragma unroll
            for (int j = 0; j < 4; ++j) { const f32x4 v = *(const f32x4*)(xr + 4 * lane + 256 * j); *(f32x4*)(V + (size_t)m * DM + 4 * lane + 256 * j) = v;
                u32x2 w; w.x = pk2(v[0], v[1]); w.y = pk2(v[2], v[3]); *(u32x2*)(VB + (size_t)m * DM + 4 * lane + 256 * j) = w; }
            if (lane == 0) { st0[2 * m] = 0; st0[2 * m + 1] = (i64)((float)DM * (1.0f - LN_EPS) * FXS); }
        }
        if (blockIdx.x == 0) { float* o = (float*)(ws + WS_ONES); for (int i = tid; i < 2048; i += 512) o[i] = i < 1024 ? 1.f : 0.f; }
    }
}

__device__ __forceinline__ void prep_item(const Params& P, int l, int ci, int h, LAS unsigned char* lds) {
    int tid = threadIdx.x; asm volatile("" : "+v"(tid));
    const int c = tid & 127, rg = tid >> 7;
    LAS float* glr_s = (LAS float*)lds; LAS float* tot_s = glr_s + 1024;
    const size_t r0 = (size_t)ci * 64;
    const float* glr = (const float*)(P.ws + WS_GLR) + r0 * 16;
    if (tid < 256) ((LAS f32x4*)glr_s)[tid] = ((const f32x4*)glr)[tid];
    float w[16];
#pragma unroll
    for (int j = 0; j < 16; ++j) w[j] = P.in[I_WA2][(size_t)(l * 16 + j) * 512 + h * 128 + c];
    const float bias = P.in[I_BA][l * 512 + h * 128 + c];
    __syncthreads();
    float lg[16];
#pragma unroll
    for (int i = 0; i < 16; ++i) { const LAS f32x4* gr = (const LAS f32x4*)(glr_s + (rg * 16 + i) * 16); float x = bias;
#pragma unroll
        for (int q = 0; q < 4; ++q) { const f32x4 g4 = gr[q]; x += g4[0] * w[4 * q] + g4[1] * w[4 * q + 1] + g4[2] * w[4 * q + 2] + g4[3] * w[4 * q + 3]; }
        lg[i] = (fminf(x, 0.f) - __logf(1.0f + __expf(-fabsf(x)))) * (1.0f / 16.0f); }
#pragma unroll
    for (int i = 1; i < 16; ++i) lg[i] += lg[i - 1];
    tot_s[rg * 128 + c] = lg[15];
    __syncthreads();
    float off = 0.f, total = 0.f;
#pragma unroll
    for (int q = 0; q < 4; ++q) { const float t = tot_s[q * 128 + c]; total += t; if (q < rg) off += t; }
    bf16* Z = (bf16*)(P.ws + WS_Z);
    bf16* zq = Z + (r0 + rg * 16) * ZW + ZQ + h * 128 + c; bf16* zk = zq + (ZK - ZQ);
#pragma unroll
    for (int i = 0; i < 16; ++i) { const float b = lg[i] + off; const float q = bf2f(zq[(size_t)i * ZW]), k = bf2f(zk[(size_t)i * ZW]);
        zq[(size_t)i * ZW] = (bf16)f2bf(q * __expf(b)); zk[(size_t)i * ZW] = (bf16)f2bf(k * __expf(-b)); }
    if (rg == 0) ((float*)(P.ws + WS_DEC))[((size_t)ci * 4 + h) * 128 + c] = __expf(total);
    __syncthreads();
}

__device__ __forceinline__ void gmlp_item(const Params& P, int l, int it, LAS unsigned char* lds) {
    int tid = threadIdx.x; asm volatile("" : "+v"(tid));
    const int w = tid >> 6, lane = tid & 63, fr = lane & 15, fq = lane >> 4;
    const int cidx = it >> 2, g = it & 3;
    const bool samp = cidx >= 256; const int nrows = samp ? 64 : 128; const size_t r0 = samp ? (size_t)MP + (size_t)(cidx - 256) * 64 : (size_t)cidx * 128;
    constexpr int VP = 136;
    LAS bf16* vnT = (LAS bf16*)lds;
    bf16* Z = (bf16*)(P.ws + WS_Z); const i64* gst = (const i64*)(P.ws + WS_GST) + (size_t)l * MT * 2;
    const float* gmg = P.in[I_GMG] + l * 512 + g * 128; const float* gmb = P.in[I_GMB] + l * 512 + g * 128;
    { const int seg = tid & 15; f32x4 g0 = *(const f32x4*)(gmg + seg * 8), g1 = *(const f32x4*)(gmg + seg * 8 + 4), b0 = *(const f32x4*)(gmb + seg * 8), b1 = *(const f32x4*)(gmb + seg * 8 + 4);
#pragma unroll
      for (int i = 0; i < 4; ++i) { const int row = (tid >> 4) + 32 * i; float vn[8];
        if (row < nrows) { const u32x4 raw = *(const u32x4*)(Z + (r0 + row) * ZW + ZV + g * 128 + seg * 8);
            const i64x2 s = *(const i64x2*)(gst + 2 * (r0 + row)); const float mu = (float)s.x * (FXS_INV / 512.0f), rstd = rsqrtf(fmaxf((float)s.y * (FXS_INV / 512.0f) - mu * mu, 0.f) + LN_EPS);
            vn[0] = (bflo(raw.x) - mu) * rstd * g0[0] + b0[0]; vn[1] = (bfhi(raw.x) - mu) * rstd * g0[1] + b0[1]; vn[2] = (bflo(raw.y) - mu) * rstd * g0[2] + b0[2]; vn[3] = (bfhi(raw.y) - mu) * rstd * g0[3] + b0[3];
            vn[4] = (bflo(raw.z) - mu) * rstd * g1[0] + b1[0]; vn[5] = (bfhi(raw.z) - mu) * rstd * g1[1] + b1[1]; vn[6] = (bflo(raw.w) - mu) * rstd * g1[2] + b1[2]; vn[7] = (bfhi(raw.w) - mu) * rstd * g1[3] + b1[3];
            if (samp) { float* vo = P.out + OUT_VN + ((size_t)(l * DBATCH + (cidx - 256)) * DSEQ + row) * 512 + g * 128 + seg * 8;
                *(f32x4*)vo = (f32x4){vn[0], vn[1], vn[2], vn[3]}; *(f32x4*)(vo + 4) = (f32x4){vn[4], vn[5], vn[6], vn[7]}; }
        } else {
#pragma unroll
            for (int e = 0; e < 8; ++e) vn[e] = 0.f; }
#pragma unroll
        for (int e = 0; e < 8; ++e) vnT[(seg * 8 + e) * VP + row] = (bf16)f2bf(vn[e]);
      } }
    __syncthreads();
    if (16 * w < nrows) {
        const bf16* Wg = (const bf16*)(P.ws + WS_WSB) + (size_t)g * 16384 + (size_t)(16 * w + fr) * 128 + 8 * fq;
        const int nks = ((16 * w + 15) >> 5) + 1;
        bf16x8 fa[4];
#pragma unroll
        for (int ks = 0; ks < 4; ++ks) fa[ks] = (ks < nks) ? *(const bf16x8*)(Wg + 32 * ks) : (bf16x8){0, 0, 0, 0, 0, 0, 0, 0};
        const size_t rr = r0 + 16 * w + fr; const float bsv = P.in[I_GMBS][(size_t)(l * 4 + g) * 128 + 16 * w + fr];
#pragma unroll
        for (int dt = 0; dt < 8; ++dt) {
            f32x4 a = (f32x4){0.f, 0.f, 0.f, 0.f};
#pragma unroll
            for (int ks = 0; ks < 4; ++ks) if (ks < nks) { const bf16x8 fv = *(const LAS bf16x8*)(vnT + (16 * dt + fr) * VP + 32 * ks + 8 * fq); a = __builtin_amdgcn_mfma_f32_16x16x32_bf16(fv, fa[ks], a, 0, 0, 0); }
            bf16* up = Z + rr * ZW + ZU + g * 128 + 16 * dt + 4 * fq; const u32x2 uu = *(const u32x2*)up;
            u32x2 o; o.x = pk2(bflo(uu.x) * (a[0] + bsv), bfhi(uu.x) * (a[1] + bsv)); o.y = pk2(bflo(uu.y) * (a[2] + bsv), bfhi(uu.y) * (a[3] + bsv));
            *(u32x2*)up = o;
        }
    }
    __syncthreads();
}

__device__ __forceinline__ void scan_item(const Params& P, int l, int sidx, int h, LAS unsigned char* lds) {
    int tid = threadIdx.x; asm volatile("" : "+v"(tid));
    const int w = tid >> 6, lane = tid & 63, fr = lane & 15, fq = lane >> 4;
    const bool samp = sidx >= NBATCH; const int nch = samp ? 1 : SEQ / 64; const int c0 = samp ? (MP / 64 + (sidx - NBATCH)) : sidx * (SEQ / 64);
    constexpr int QP = 136, TP = 72;
    LAS bf16* qe_s = (LAS bf16*)lds;
    LAS bf16* ke_s = qe_s + 64 * QP;
    LAS bf16* kdT = ke_s + 64 * QP;
    LAS bf16* vT = kdT + 128 * TP;
    LAS bf16* att_s = vT + 256 * TP;
    LAS float* dec_s = (LAS float*)(att_s + 64 * TP);
    LAS float* red_s = dec_s + 128;
    bf16* Z = (bf16*)(P.ws + WS_Z); const float* DEC = (const float*)(P.ws + WS_DEC);
    f32x4 S[2][8];
    if (samp) { const float* S0 = P.in[I_STATE] + ((size_t)(l * DBATCH + (sidx - NBATCH)) * 4 + h) * 32768;
        const float* sp = S0 + (size_t)(4 * fq) * 256 + 32 * w + fr;
#pragma unroll
        for (int kt = 0; kt < 8; ++kt) {
#pragma unroll
            for (int d = 0; d < 2; ++d)
#pragma unroll
                for (int j = 0; j < 4; ++j) S[d][kt][j] = sp[j * 256 + 16 * d];
            sp += 16 * 256; asm volatile("" : "+v"(sp) :: "memory"); }
    } else {
#pragma unroll
        for (int d = 0; d < 2; ++d)
#pragma unroll
            for (int kt = 0; kt < 8; ++kt) S[d][kt] = (f32x4){0.f, 0.f, 0.f, 0.f}; }
    const float* gnp = P.in[I_GNG] + l * 256 + 32 * w + 4 * fq;
    u32x4 qv[2], kv[2], vv[4]; float dcv = 0.f;
    const int seg16 = tid & 15, rowq = tid >> 4, seg32 = tid & 31, rowv = tid >> 5;
#define SCAN_LOAD_QK(ci) do { const size_t rb = (size_t)(ci) * 64; \
        _Pragma("unroll") for (int i = 0; i < 2; ++i) { const bf16* p = Z + (rb + rowq + 32 * i) * ZW + h * 128 + seg16 * 8; qv[i] = *(const u32x4*)(p + ZQ); kv[i] = *(const u32x4*)(p + ZK); } \
        if (tid < 128) dcv = DEC[((size_t)(ci) * 4 + h) * 128 + tid]; } while (0)
#define SCAN_LOAD_V(ci) do { const size_t rb = (size_t)(ci) * 64; \
        _Pragma("unroll") for (int i = 0; i < 4; ++i) vv[i] = *(const u32x4*)(Z + (rb + rowv + 16 * i) * ZW + ZVG + h * 256 + seg32 * 8); } while (0)
    SCAN_LOAD_QK(c0); SCAN_LOAD_V(c0);
    for (int n = 0; n < nch; ++n) {
        const size_t r0 = (size_t)(c0 + n) * 64;
#pragma unroll
        for (int i = 0; i < 2; ++i) { const int row = rowq + 32 * i;
            *(LAS u32x4*)(qe_s + row * QP + seg16 * 8) = qv[i]; *(LAS u32x4*)(ke_s + row * QP + seg16 * 8) = kv[i];
            const unsigned kw[4] = {kv[i].x, kv[i].y, kv[i].z, kv[i].w};
#pragma unroll
            for (int e = 0; e < 4; ++e) { kdT[(seg16 * 8 + 2 * e) * TP + row] = (bf16)(kw[e] & 0xffffu); kdT[(seg16 * 8 + 2 * e + 1) * TP + row] = (bf16)(kw[e] >> 16); } }
#pragma unroll
        for (int i = 0; i < 4; ++i) { const int row = rowv + 16 * i; const unsigned vw[4] = {vv[i].x, vv[i].y, vv[i].z, vv[i].w};
#pragma unroll
            for (int e = 0; e < 4; ++e) { vT[(seg32 * 8 + 2 * e) * TP + row] = (bf16)(vw[e] & 0xffffu); vT[(seg32 * 8 + 2 * e + 1) * TP + row] = (bf16)(vw[e] >> 16); } }
        if (tid < 128) dec_s[tid] = dcv;
        __syncthreads();
        if (n + 1 < nch) SCAN_LOAD_QK(c0 + n + 1);
        __builtin_amdgcn_sched_barrier(0);
        { const int tt = w >> 1;
#pragma unroll
          for (int si = 0; si < 2; ++si) { const int st = 2 * (w & 1) + si; f32x4 a = (f32x4){0.f, 0.f, 0.f, 0.f};
            if (st <= tt) {
#pragma unroll
                for (int ks = 0; ks < 4; ++ks) { const bf16x8 fk = *(const LAS bf16x8*)(ke_s + (16 * st + fr) * QP + 32 * ks + 8 * fq), fqv = *(const LAS bf16x8*)(qe_s + (16 * tt + fr) * QP + 32 * ks + 8 * fq);
                    a = __builtin_amdgcn_mfma_f32_16x16x32_bf16(fk, fqv, a, 0, 0, 0); }
#pragma unroll
                for (int j = 0; j < 4; ++j) if (16 * st + 4 * fq + j > 16 * tt + fr) a[j] = 0.f; }
            u32x2 o; o.x = pk2(a[0], a[1]); o.y = pk2(a[2], a[3]); *(LAS u32x2*)(att_s + (16 * tt + fr) * TP + 16 * st + 4 * fq) = o; } }
        __syncthreads();
        __builtin_amdgcn_sched_barrier(0);
        f32x4 O[4][2];
#pragma unroll
        for (int tt = 0; tt < 4; ++tt)
#pragma unroll
            for (int d = 0; d < 2; ++d) O[tt][d] = (f32x4){0.f, 0.f, 0.f, 0.f};
#pragma unroll
        for (int ks = 0; ks < 2; ++ks) { bf16x8 fv[2];
#pragma unroll
            for (int d = 0; d < 2; ++d) fv[d] = *(const LAS bf16x8*)(vT + (32 * w + 16 * d + fr) * TP + 32 * ks + 8 * fq);
#pragma unroll
            for (int tt = 0; tt < 4; ++tt) { const bf16x8 fa = *(const LAS bf16x8*)(att_s + (16 * tt + fr) * TP + 32 * ks + 8 * fq);
#pragma unroll
                for (int d = 0; d < 2; ++d) O[tt][d] = __builtin_amdgcn_mfma_f32_16x16x32_bf16(fv[d], fa, O[tt][d], 0, 0, 0); } }
        __builtin_amdgcn_sched_barrier(0);
#pragma unroll
        for (int ks = 0; ks < 4; ++ks) { bf16x8 fs[2];
#pragma unroll
            for (int d = 0; d < 2; ++d) { const f32x4 s0 = S[d][2 * ks], s1 = S[d][2 * ks + 1]; u32x4 pkd; pkd.x = pk2(s0[0], s0[1]); pkd.y = pk2(s0[2], s0[3]); pkd.z = pk2(s1[0], s1[1]); pkd.w = pk2(s1[2], s1[3]); fs[d] = __builtin_bit_cast(bf16x8, pkd); }
#pragma unroll
            for (int tt = 0; tt < 4; ++tt) { const LAS bf16* qp = qe_s + (16 * tt + fr) * QP + 32 * ks + 4 * fq; const u32x2 lo = *(const LAS u32x2*)qp, hi = *(const LAS u32x2*)(qp + 16);
                const bf16x8 fqp = __builtin_bit_cast(bf16x8, ((u32x4){lo.x, lo.y, hi.x, hi.y}));
#pragma unroll
                for (int d = 0; d < 2; ++d) O[tt][d] = __builtin_amdgcn_mfma_f32_16x16x32_bf16(fs[d], fqp, O[tt][d], 0, 0, 0); } }
        __builtin_amdgcn_sched_barrier(0);
#pragma unroll
        for (int ks = 0; ks < 2; ++ks) { bf16x8 fv[2];
#pragma unroll
            for (int d = 0; d < 2; ++d) fv[d] = *(const LAS bf16x8*)(vT + (32 * w + 16 * d + fr) * TP + 32 * ks + 8 * fq);
#pragma unroll
            for (int kt = 0; kt < 8; ++kt) { const bf16x8 fk = *(const LAS bf16x8*)(kdT + (16 * kt + fr) * TP + 32 * ks + 8 * fq);
#pragma unroll
                for (int d = 0; d < 2; ++d) S[d][kt] = __builtin_amdgcn_mfma_f32_16x16x32_bf16(fk, fv[d], S[d][kt], 0, 0, 0); } }
#pragma unroll
        for (int kt = 0; kt < 8; ++kt) { const f32x4 dc = *(const LAS f32x4*)(dec_s + 16 * kt + 4 * fq);
#pragma unroll
            for (int d = 0; d < 2; ++d) S[d][kt] = S[d][kt] * dc; }
        __builtin_amdgcn_sched_barrier(0);
        if (n + 1 < nch) SCAN_LOAD_V(c0 + n + 1);
        __builtin_amdgcn_sched_barrier(0);
#pragma unroll
        for (int tt = 0; tt < 4; ++tt) { float ss = 0.f;
#pragma unroll
            for (int d = 0; d < 2; ++d) ss += (O[tt][d][0] * O[tt][d][0] + O[tt][d][1] * O[tt][d][1]) + (O[tt][d][2] * O[tt][d][2] + O[tt][d][3] * O[tt][d][3]);
            ss += __shfl_xor(ss, 16); ss += __shfl_xor(ss, 32);
            if (fq == 0) red_s[w * 64 + 16 * tt + fr] = ss; }
        __syncthreads();
#pragma unroll
        for (int tt = 0; tt < 4; ++tt) { float tot = 0.f;
#pragma unroll
            for (int q = 0; q < 8; ++q) tot += red_s[q * 64 + 16 * tt + fr];
            const float rstd = rsqrtf(tot * (1.0f / 256.0f) + LN_EPS);
            bf16* zr = Z + (r0 + 16 * tt + fr) * ZW + h * 256 + 32 * w + 4 * fq;
#pragma unroll
            for (int d = 0; d < 2; ++d) { const u32x2 gg = *(const u32x2*)(zr + ZGG + 16 * d); const f32x4 o = O[tt][d] * rstd * *(const f32x4*)(gnp + 16 * d);
                u32x2 ow; ow.x = pk2(o[0] * bflo(gg.x), o[1] * bfhi(gg.x)); ow.y = pk2(o[2] * bflo(gg.y), o[3] * bfhi(gg.y));
                *(u32x2*)(zr + ZVG + 16 * d) = ow; } }
    }
#undef SCAN_LOAD_QK
#undef SCAN_LOAD_V
    float* So = samp ? P.out + OUT_SS + ((size_t)(l * DBATCH + (sidx - NBATCH)) * 4 + h) * 32768 : P.out + OUT_SP + ((size_t)(l * NBATCH + sidx) * 4 + h) * 32768;
    So += (size_t)(4 * fq) * 256 + 32 * w + fr;
#pragma unroll
    for (int kt = 0; kt < 8; ++kt) {
#pragma unroll
        for (int d = 0; d < 2; ++d)
#pragma unroll
            for (int j = 0; j < 4; ++j) So[j * 256 + 16 * d] = S[d][kt][j];
        So += 16 * 256; asm volatile("" : "+v"(So) :: "memory"); }
    __syncthreads();
}

#ifndef GEMSEL
#define GEMSEL 255
#endif
#ifndef PHM
#define PHM 31
#endif
#if PHM & 8
#define SCAN_CALL scan_item
#else
#define SCAN_CALL(...) do {} while (0)
#endif
#if PHM & 16
#define GMLP_CALL gmlp_item
#else
#define GMLP_CALL(...) do {} while (0)
#endif
template <class Epi> __device__ __forceinline__ void run_gemm(LAS unsigned char* lds, const bf16* A, int lda, const bf16* Bt, int N, int K, const Epi& E) {
    pg8::Gemm g{A, Bt, lda, MT, N, K}; pg8::StaticOrder S; S.init(MT, N, (int)gridDim.x, (int)blockIdx.x);
#if PHM & 2
    pg8::gemm_phase<Epi, pg8::StaticOrder, true, true>((PG8_LAS unsigned char*)lds, g, S, E);
#endif
}

__global__ void __launch_bounds__(512, 2) fwd_megakernel(Params P) {
    extern __shared__ __attribute__((aligned(16))) unsigned char lds_raw[];
    LAS unsigned char* lds = (LAS unsigned char*)lds_raw;
    cg::grid_group grid = cg::this_grid();
#define GRID_SYNC() do { asm volatile("s_waitcnt vmcnt(0) lgkmcnt(0)" ::: "memory"); grid.sync(); __builtin_amdgcn_fence(__ATOMIC_ACQUIRE, "agent"); asm volatile("s_waitcnt vmcnt(0)" ::: "memory"); } while (0)
    unsigned char* ws = P.ws; const int G = gridDim.x, bx = blockIdx.x, tid = threadIdx.x;
    float* V = P.out; bf16* VB = (bf16*)(ws + WS_VB); bf16* Z = (bf16*)(ws + WS_Z); bf16* H = Z;
    i64* stats = (i64*)(ws + WS_STATS);
    const float* lng = P.in[I_LNG]; const float* lnb = P.in[I_LNB];
    const float* ones = (const float*)(ws + WS_ONES); const float* zeros = ones + 1024;
    for (int l = 0; l < DEPTH; ++l) {
        i64* cscb = (i64*)(ws + WS_CSCB) + (size_t)l * CSCB_L;
        i64 *cs13a = cscb, *cb13a = cscb + NUP, *csin = cscb + 2 * NUP, *cbin = csin + NIN, *cs13b = cbin + NIN, *cb13b = cs13b + NUP;
        i64* st0 = stats + (size_t)(3 * l) * MT * 2; i64* st1 = st0 + (size_t)MT * 2; i64* st2 = st1 + (size_t)MT * 2; i64* st3 = st2 + (size_t)MT * 2;
        const float* g_prev = l ? lng + ((l - 1) * 3 + 2) * DM : ones; const float* b_prev = l ? lnb + ((l - 1) * 3 + 2) * DM : zeros;
#if PHM & 1
        convert_phase(P, l, lds);
#endif
        GRID_SYNC();
        { EpiUp E{H, st0, cs13a, cb13a}; if (GEMSEL & 1) run_gemm(lds, VB, DM, (const bf16*)(ws + WS_W13A), NUP, DM, E); }
        GRID_SYNC();
        { EpiRes E{V, VB, st0, g_prev, b_prev, st1, 0.5f}; if (GEMSEL & 2) run_gemm(lds, H, DFF, (const bf16*)(ws + WS_W2A), DM, DFF, E); }
        GRID_SYNC();
        { EpiZ E{Z, st1, csin, cbin, (i64*)(ws + WS_GST) + (size_t)l * MT * 2, (float*)(ws + WS_GLR)}; if (GEMSEL & 4) run_gemm(lds, VB, DM, (const bf16*)(ws + WS_WIN), NIN, DM, E); }
        GRID_SYNC();
#if PHM & 4
        for (int it = bx; it < NCHUNK * 4; it += G) prep_item(P, l, it >> 2, it & 3, lds);
#endif
        GRID_SYNC();
        { const int nscan = (NBATCH + DBATCH) * 4, ns = G >= 2 * nscan ? nscan : G;
          if (G >= 2 * nscan) { if (bx < nscan) SCAN_CALL(P, l, bx >> 2, bx & 3, lds); else for (int it = bx - nscan; it < (256 + DBATCH) * 4; it += G - nscan) GMLP_CALL(P, l, it, lds); }
          else { for (int it = bx; it < nscan; it += ns) SCAN_CALL(P, l, it >> 2, it & 3, lds); for (int it = bx; it < (256 + DBATCH) * 4; it += G) GMLP_CALL(P, l, it, lds); } }
        GRID_SYNC();
        { EpiGate<false> E{Z}; if (GEMSEL & 8) run_gemm(lds, Z + ZU, ZW, (const bf16*)(ws + WS_WPA), DM, 512, E); }
        GRID_SYNC();
        { EpiGate<true> E{Z}; if (GEMSEL & 16) run_gemm(lds, Z + ZVG, ZW, (const bf16*)(ws + WS_WPB), DM, DM, E); }
        GRID_SYNC();
        { EpiRes E{V, VB, st1, lng + (l * 3) * DM, lnb + (l * 3) * DM, st2, 1.0f}; if (GEMSEL & 32) run_gemm(lds, Z + ZGB, ZW, (const bf16*)(ws + WS_WO), DM, DM, E); }
        GRID_SYNC();
        { EpiUp E{H, st2, cs13b, cb13b}; if (GEMSEL & 64) run_gemm(lds, VB, DM, (const bf16*)(ws + WS_W13B), NUP, DM, E); }
        GRID_SYNC();
        { EpiRes E{V, VB, st2, lng + (l * 3 + 1) * DM, lnb + (l * 3 + 1) * DM, st3, 0.5f}; if (GEMSEL & 128) run_gemm(lds, H, DFF, (const bf16*)(ws + WS_W2B), DM, DFF, E); }
        GRID_SYNC();
    }
    { const i64* st = stats + (size_t)12 * MT * 2; const float* g = lng + 11 * DM; const float* b = lnb + 11 * DM; const int lane = tid & 63, wave = tid >> 6;
      f32x4 gv[4], bv[4];
#pragma unroll
      for (int j = 0; j < 4; ++j) { gv[j] = *(const f32x4*)(g + 4 * lane + 256 * j); bv[j] = *(const f32x4*)(b + 4 * lane + 256 * j); }
      for (int m = bx * 8 + wave; m < MT; m += G * 8) { float mu, rstd; row_stat(st, m, mu, rstd); float* vr = V + (size_t)m * DM + 4 * lane;
#pragma unroll
          for (int j = 0; j < 4; ++j) { const f32x4 v = *(const f32x4*)(vr + 256 * j); *(f32x4*)(vr + 256 * j) = (v - mu) * rstd * gv[j] + bv[j]; } } }
}

extern "C" void kernel_launch(void* const* d_in, const int* in_sizes, int n_in, void* d_out, int out_size, void* d_ws, size_t ws_size, hipStream_t stream) {
    static int grid = 0;
    if (grid == 0) {
        if (n_in != 19 || (size_t)out_size != OUT_END || ws_size < WS_END) { fprintf(stderr, "kernel_launch: unexpected shapes: n_in %d out %d ws %zu (need %zu)\n", n_in, out_size, ws_size, (size_t)WS_END); grid = -1; return; }
        int dev = 0, cus = 0, per_cu = 0;
        if (hipGetDevice(&dev) != hipSuccess || hipDeviceGetAttribute(&cus, hipDeviceAttributeMultiprocessorCount, dev) != hipSuccess) { grid = -1; return; }
        if (hipFuncSetAttribute((const void*)fwd_megakernel, hipFuncAttributeMaxDynamicSharedMemorySize, LDS_BYTES) != hipSuccess) { fprintf(stderr, "kernel_launch: hipFuncSetAttribute failed\n"); grid = -1; return; }
        if (hipOccupancyMaxActiveBlocksPerMultiprocessor(&per_cu, (const void*)fwd_megakernel, 512, LDS_BYTES) != hipSuccess || per_cu < 1) { fprintf(stderr, "kernel_launch: occupancy query gives %d\n", per_cu); per_cu = 1; }
        (void)hipGetLastError();
        grid = cus;
    }
    if (grid < 0) return;
    (void)hipMemsetAsync(d_ws, 0, ZERO_BYTES, stream);
    Params p{};
    for (int i = 0; i < 19; ++i) p.in[i] = (const float*)d_in[i];
    p.out = (float*)d_out; p.ws = (unsigned char*)d_ws;
    void* args[] = {&p};
    hipError_t e = hipLaunchCooperativeKernel((const void*)fwd_megakernel, dim3(grid), dim3(512), args, LDS_BYTES, stream);
    if (e != hipSuccess) fprintf(stderr, "cooperative launch failed: %s (grid %d)\n", hipGetErrorString(e), grid);
}
```

```cpp
#include <hip/hip_runtime.h>
#include <hip/hip_cooperative_groups.h>
#include <cstdio>
#include <cstdint>
namespace cg = cooperative_groups;

namespace pg8 {
#define PG8_LAS __attribute__((address_space(3)))
typedef unsigned short bf16_t;
typedef short bf16x8 __attribute__((ext_vector_type(8)));
typedef float f32x4 __attribute__((ext_vector_type(4)));
typedef unsigned u32x4 __attribute__((ext_vector_type(4)));
constexpr int BM = 256, BK = 64, HALF = 128, HTB = HALF * BK * 2  , STAGE_BYTES = 8 * HTB, NXCD = 8, WGM = 8;

__host__ __device__ __forceinline__ int lds_byte(int r, int c) { const int st = (r >> 4) * 2 + (c >> 5), rr = r & 15, cc = c & 31, ob = rr * 64 + cc * 2; return st * 1024 + (ob ^ (((ob >> 9) & 1) << 5)); }
__host__ __device__ __forceinline__ void stage_rc(int b, int& R, int& C) { const int st = b / 1024, sb = b % 1024, swz = sb ^ (((sb >> 9) & 1) << 5); R = (st >> 1) * 16 + swz / 64; C = (st & 1) * 32 + (swz % 64) / 2; }
__host__ __device__ __forceinline__ int perm32(int rho) { const int n = rho >> 4, i = rho & 15; return 8 * (i >> 2) + 4 * n + (i & 3); }

struct Unit { int pm, pn; };
struct Gemm { const bf16_t* A; const bf16_t* Bt; int lda, M, N, K; };

struct StaticOrder {
    int nM, nN, nwg, G, c;
    __host__ __device__ void init(int M, int N, int G_, int c_) { nM = M / BM; nN = N / BM; nwg = nM * nN; G = G_; c = c_; }
    __host__ __device__ bool next(int i, Unit& u) const {
        const long L = (long)i * G + c; if (L >= nwg) return false;
        int wgid = (int)L; { const int q = nwg / NXCD, r = nwg % NXCD, xcd = wgid % NXCD, off = wgid / NXCD; wgid = (xcd < r ? xcd * (q + 1) : r * (q + 1) + (xcd - r) * q) + off; }
        const int nig = WGM * nN, gid = wgid / nig, fm = gid * WGM, gsz = (nM - fm) < WGM ? (nM - fm) : WGM;
        u.pm = fm + ((wgid % nig) % gsz); u.pn = (wgid % nig) / gsz; return true;
    }
    __device__ __forceinline__ void a_ready(const Unit&) const {}
    __device__ __forceinline__ void done(const Unit&) const {}
};
__device__ __forceinline__ unsigned cvt_pk_bf16(float lo, float hi) { unsigned r; asm volatile("v_cvt_pk_bf16_f32 %0, %1, %2" : "=v"(r) : "v"(lo), "v"(hi)); return r; }
typedef float f32x2 __attribute__((ext_vector_type(2)));
__device__ __forceinline__ f32x2 gelu_pk(f32x2 v) {
    const f32x2 av = __builtin_elementwise_abs(v), d = av * 0.2316418882f + 1.0f;
    f32x2 t; t.x = __builtin_amdgcn_rcpf(d.x); t.y = __builtin_amdgcn_rcpf(d.y);
    f32x2 q = t * 0.5307027145f + (-0.7265760135f); q = q * t + 0.7107068705f; q = q * t + (-0.142248368f); q = q * t + 0.127414796f; q = q * t;
    const f32x2 s = (v * v) * (-0.72134752044f);
    f32x2 e; e.x = __builtin_amdgcn_exp2f(s.x); e.y = __builtin_amdgcn_exp2f(s.y);
    const f32x2 m = v * (q * e), r = v - m;
    f32x2 o; o.x = v.x < 0.f ? m.x : r.x; o.y = v.y < 0.f ? m.y : r.y; return o;
}

template <class Epi, class Sched, bool ALIGN_EPI = false, bool SP2 = false>
__device__ __forceinline__ void gemm_phase(PG8_LAS unsigned char* lds, const Gemm g, const Sched& S, const Epi& E) {
    int tid = threadIdx.x; asm volatile("" : "+v"(tid));
    const int wid = __builtin_amdgcn_readfirstlane(tid >> 6), lane = tid & 63, wr = wid >> 2, wc = wid & 3, fr = lane & 15, fq = lane >> 4;
    const int K = g.K, nt = K / BK;
    unsigned voffA[2], voffB[2];
#pragma unroll
    for (int i = 0; i < 2; ++i) { int R, C; stage_rc(tid * 16 + i * 8192, R, C); const int Rb = Epi::PERM ? ((R & ~31) + perm32(R & 31)) : R;
        voffA[i] = (unsigned)(R * g.lda + C) * 2u; voffB[i] = (unsigned)(Rb * K + C) * 2u; }
    const size_t kstep = (size_t)(BK * 2);
    const size_t hstepA = (size_t)HALF * g.lda * 2, hstepB = (size_t)HALF * K * 2;
    const size_t tstepA = 2 * hstepA, tstepB = 2 * hstepB;
    const unsigned ldsw = (unsigned)wid * 1024u;
    const int aoff = lds_byte(wr * 64 + fr, fq * 8), boff = lds_byte(wc * 32 + fr, fq * 8);
#define PG8_SA(b, h) (((b) * 2 + (h)) * HTB)
#define PG8_SB(b, h) ((4 + (b) * 2 + (h)) * HTB)
#define PG8_STAGE(bufoff, gbase, voff) do { _Pragma("unroll") for (int _i = 0; _i < 2; ++_i) \
        __builtin_amdgcn_global_load_lds((const unsigned*)((const char*)(gbase) + (voff)[_i]), (PG8_LAS unsigned*)(lds + (bufoff) + ldsw + _i * 8192), 16, 0, 0); } while (0)
#define PG8_LDA(dst, b, h) do { _Pragma("unroll") for (int m = 0; m < 4; ++m) _Pragma("unroll") for (int k = 0; k < 2; ++k) dst[m][k] = *(const PG8_LAS bf16x8*)(lds + PG8_SA(b, h) + aoff + m * 2048 + k * 1024); } while (0)
#define PG8_LDB(dst, b, h) do { _Pragma("unroll") for (int n = 0; n < 2; ++n) _Pragma("unroll") for (int k = 0; k < 2; ++k) dst[n][k] = *(const PG8_LAS bf16x8*)(lds + PG8_SB(b, h) + boff + n * 2048 + k * 1024); } while (0)
#define PG8_MMA(ai, bj, At, Bt) do { __builtin_amdgcn_s_setprio(1); _Pragma("unroll") for (int m = 0; m < 4; ++m) _Pragma("unroll") for (int n = 0; n < 2; ++n) _Pragma("unroll") for (int k = 0; k < 2; ++k) \
        acc[ai][bj][m][n] = __builtin_amdgcn_mfma_f32_16x16x32_bf16(Bt[n][k], At[m][k], acc[ai][bj][m][n], 0, 0, 0); __builtin_amdgcn_s_setprio(0); } while (0)
#define PG8_WAIT_V(n) asm volatile("s_waitcnt vmcnt(" #n ")" ::: "memory")
#define PG8_WAIT_L(n) asm volatile("s_waitcnt lgkmcnt(" #n ")" ::: "memory")
#define PG8_BAR __builtin_amdgcn_s_barrier()
#define PG8_SCHED __builtin_amdgcn_sched_barrier(0)
    Unit cur, nxt; int ui = 0;
    if (!S.next(0, cur)) return;
    f32x4 acc[2][2][4][2];
#pragma unroll
    for (int a = 0; a < 2; ++a)
#pragma unroll
        for (int b = 0; b < 2; ++b)
#pragma unroll
            for (int m = 0; m < 4; ++m)
#pragma unroll
                for (int n = 0; n < 2; ++n) acc[a][b][m][n] = (f32x4){0.f, 0.f, 0.f, 0.f};
    bf16x8 At[4][2], B0[2][2], B1[2][2];
    const char* cA = (const char*)g.A + (size_t)cur.pm * tstepA; const char* cB = (const char*)g.Bt + (size_t)cur.pn * tstepB;
    S.a_ready(cur);
    if constexpr (SP2) {
        PG8_STAGE(PG8_SB(0, 0), cB, voffB); PG8_STAGE(PG8_SB(0, 1), cB + hstepB, voffB); PG8_STAGE(PG8_SA(0, 0), cA, voffA); PG8_STAGE(PG8_SA(0, 1), cA + hstepA, voffA);
        if (wr == 1) PG8_BAR;
        PG8_WAIT_V(2); PG8_BAR;
        PG8_STAGE(PG8_SB(1, 0), cB + kstep, voffB); PG8_STAGE(PG8_SA(1, 0), cA + kstep, voffA); PG8_STAGE(PG8_SB(1, 1), cB + hstepB + kstep, voffB);
        PG8_WAIT_V(6); PG8_BAR;
    } else {
        PG8_STAGE(PG8_SB(0, 0), cB, voffB); PG8_STAGE(PG8_SA(0, 0), cA, voffA); PG8_STAGE(PG8_SB(0, 1), cB + hstepB, voffB); PG8_STAGE(PG8_SA(0, 1), cA + hstepA, voffA);
        if (wr == 1) PG8_BAR;
        PG8_WAIT_V(4); PG8_BAR;
        PG8_STAGE(PG8_SB(1, 0), cB + kstep, voffB); PG8_STAGE(PG8_SA(1, 0), cA + kstep, voffA); PG8_STAGE(PG8_SB(1, 1), cB + hstepB + kstep, voffB);
        PG8_WAIT_V(6); PG8_BAR;
    }
    for (;;) {
        const bool has_next = S.next(ui + 1, nxt);
        const char* nA = has_next ? (const char*)g.A + (size_t)nxt.pm * tstepA : cA; const char* nB = has_next ? (const char*)g.Bt + (size_t)nxt.pn * tstepB : cB;
        for (int t = 0; t < nt; t += 2) {
            const bool last = (t == nt - 2);
            const char* a1 = cA + (size_t)(t + 1) * kstep;
            const char* a2 = last ? nA : cA + (size_t)(t + 2) * kstep; const char* b2 = last ? nB : cB + (size_t)(t + 2) * kstep;
            const char* a3 = a2 + kstep; const char* b3 = b2 + kstep;
            if (last && has_next) S.a_ready(nxt);
            if constexpr (SP2) {
            PG8_LDB(B0, 0, 0); PG8_LDB(B1, 0, 1); PG8_SCHED; PG8_LDA(At, 0, 0); PG8_STAGE(PG8_SA(1, 1), a1 + hstepA, voffA);
            PG8_WAIT_V(8); PG8_WAIT_L(0); PG8_BAR; PG8_MMA(0, 0, At, B0); PG8_MMA(0, 1, At, B1); PG8_BAR; PG8_SCHED;
            PG8_LDA(At, 0, 1); PG8_STAGE(PG8_SB(0, 0), b2, voffB); PG8_STAGE(PG8_SB(0, 1), b2 + hstepB, voffB); PG8_STAGE(PG8_SA(0, 0), a2, voffA);
            PG8_WAIT_V(8); PG8_WAIT_L(0); PG8_BAR; PG8_MMA(1, 0, At, B0); PG8_MMA(1, 1, At, B1); PG8_BAR; PG8_SCHED;
            PG8_LDB(B0, 1, 0); PG8_LDB(B1, 1, 1); PG8_SCHED; PG8_LDA(At, 1, 0); PG8_STAGE(PG8_SA(0, 1), a2 + hstepA, voffA);
            PG8_WAIT_V(8); PG8_WAIT_L(0); PG8_BAR; PG8_MMA(0, 0, At, B0); PG8_MMA(0, 1, At, B1); PG8_BAR; PG8_SCHED;
            PG8_LDA(At, 1, 1); PG8_STAGE(PG8_SB(1, 0), b3, voffB); PG8_STAGE(PG8_SB(1, 1), b3 + hstepB, voffB); PG8_STAGE(PG8_SA(1, 0), a3, voffA);
            PG8_WAIT_V(8); PG8_WAIT_L(0); PG8_BAR; PG8_MMA(1, 0, At, B0); PG8_MMA(1, 1, At, B1); PG8_BAR; PG8_SCHED;
            } else {
            PG8_LDB(B0, 0, 0); PG8_SCHED; PG8_LDA(At, 0, 0); PG8_STAGE(PG8_SA(1, 1), a1 + hstepA, voffA);
            PG8_WAIT_L(8); PG8_BAR; PG8_WAIT_L(0); PG8_MMA(0, 0, At, B0); PG8_BAR; PG8_SCHED;
            PG8_LDB(B1, 0, 1); PG8_STAGE(PG8_SB(0, 0), b2, voffB);
            PG8_BAR; PG8_WAIT_L(0); PG8_MMA(0, 1, At, B1); PG8_BAR;
            PG8_LDA(At, 0, 1); PG8_STAGE(PG8_SA(0, 0), a2, voffA);
            PG8_BAR; PG8_WAIT_L(0); PG8_MMA(1, 0, At, B0); PG8_BAR; PG8_SCHED;
            PG8_STAGE(PG8_SB(0, 1), b2 + hstepB, voffB);
            PG8_WAIT_V(6); PG8_BAR; PG8_MMA(1, 1, At, B1); PG8_BAR;
            PG8_LDB(B0, 1, 0); PG8_SCHED; PG8_LDA(At, 1, 0); PG8_STAGE(PG8_SA(0, 1), a2 + hstepA, voffA);
            PG8_WAIT_L(8); PG8_BAR; PG8_WAIT_L(0); PG8_MMA(0, 0, At, B0); PG8_BAR; PG8_SCHED;
            PG8_LDB(B1, 1, 1); PG8_STAGE(PG8_SB(1, 0), b3, voffB);
            PG8_BAR; PG8_WAIT_L(0); PG8_MMA(0, 1, At, B1); PG8_BAR;
            PG8_LDA(At, 1, 1); PG8_STAGE(PG8_SA(1, 0), a3, voffA);
            PG8_BAR; PG8_WAIT_L(0); PG8_MMA(1, 0, At, B0); PG8_BAR; PG8_SCHED;
            PG8_STAGE(PG8_SB(1, 1), b3 + hstepB, voffB);
            PG8_WAIT_V(6); PG8_BAR; PG8_MMA(1, 1, At, B1); PG8_BAR;
            }
        }
        if constexpr (ALIGN_EPI) { if (wr == 0) PG8_BAR; }
        if constexpr (!Epi::AFTER_DRAIN) { E(acc, cur, wr, wc, fr, fq); S.done(cur); }
        if (!has_next) break;
#pragma unroll
        for (int a = 0; a < 2; ++a)
#pragma unroll
            for (int b = 0; b < 2; ++b)
#pragma unroll
                for (int m = 0; m < 4; ++m)
#pragma unroll
                    for (int n = 0; n < 2; ++n) acc[a][b][m][n] = (f32x4){0.f, 0.f, 0.f, 0.f};
        cur = nxt; cA = nA; cB = nB; ++ui;
        if constexpr (ALIGN_EPI) { if (wr == 1) PG8_BAR; }
    }
    PG8_WAIT_V(0);
    if constexpr (!ALIGN_EPI) { if (wr == 0) PG8_BAR; }
    PG8_BAR;
    if constexpr (Epi::AFTER_DRAIN) { E.fused(acc, cur, wr, wc, fr, fq, lds, wid, lane); S.done(cur); }
#undef PG8_SA
#undef PG8_SB
#undef PG8_STAGE
#undef PG8_LDA
#undef PG8_LDB
#undef PG8_MMA
#undef PG8_WAIT_V
#undef PG8_WAIT_L
#undef PG8_BAR
#undef PG8_SCHED
}
}

#define LAS __attribute__((address_space(3)))
typedef unsigned short bf16;
typedef pg8::f32x4 f32x4;
typedef pg8::f32x2 f32x2;
typedef pg8::u32x4 u32x4;
typedef pg8::bf16x8 bf16x8;
typedef unsigned u32x2 __attribute__((ext_vector_type(2)));
constexpr int DM = 1024, NBATCH = 16, SEQ = 2048, DEPTH = 4, DBATCH = 8, DSEQ = 64;
constexpr int MP = NBATCH * SEQ, MS = DBATCH * DSEQ, MT = MP + MS;
constexpr int DFF = 2816, NUP = 2 * DFF, INC = 6160, NIN = 6400, ZW = 6144;
constexpr int ZU = 0, ZV = 512, ZQ = 1024, ZK = 1536, ZVG = 2048, ZGG = 3072, ZGA = 4096, ZGB = 5120;
constexpr size_t OZ_U = 0, OZ_V = (size_t)MT * 512, OZ_Q = (size_t)MT * 1024, OZ_K = (size_t)MT * 1536, OZ_VG = (size_t)MT * 2048, OZ_GG = (size_t)MT * 3072, OZ_GA = (size_t)MT * 4096, OZ_GB = (size_t)MT * 5120;
constexpr int NCHUNK = MT / 64;
constexpr float ALPHA = 1.6817928305074290f, LN_EPS = 1e-5f;
constexpr size_t STAT_BYTES = (size_t)MT * 2 * 4;
constexpr size_t WS_STATS = 0;
constexpr size_t WS_GST = WS_STATS + 13 * STAT_BYTES;
constexpr int CSCB_L = 2 * (NUP + NIN + NUP);
constexpr size_t ZERO_BYTES = 5u << 20;
constexpr size_t WS_CSCB = WS_GST + 4 * STAT_BYTES;
constexpr size_t WS_BAR = WS_CSCB + (size_t)DEPTH * CSCB_L * 4;
constexpr size_t WS_SUB = WS_BAR + 3456 * 4;
static_assert(WS_BAR % 256 == 0 && WS_SUB + 7 * DEPTH * 256 <= ZERO_BYTES, "zero region");
constexpr size_t WS_ONES = ZERO_BYTES;
constexpr size_t WS_W13A = WS_ONES + 65536;
constexpr size_t WS_W2A = WS_W13A + (size_t)NUP * DM * 2;
constexpr size_t WS_WIN = WS_W2A + (size_t)DM * DFF * 2;
constexpr size_t WS_WPA = WS_WIN + (size_t)NIN * DM * 2;
constexpr size_t WS_WPB = WS_WPA + (size_t)DM * 512 * 2;
constexpr size_t WS_WO = WS_WPB + (size_t)DM * DM * 2;
constexpr size_t WS_W13B = WS_WO + (size_t)DM * DM * 2;
constexpr size_t WS_W2B = WS_W13B + (size_t)NUP * DM * 2;
constexpr size_t WS_WSB = WS_W2B + (size_t)DM * DFF * 2;
constexpr size_t WS_GLR = WS_WSB + 4 * 128 * 128 * 2;
constexpr size_t WS_DEC = WS_GLR + (size_t)MT * 16 * 4;
constexpr size_t WS_VB = WS_DEC + (size_t)NCHUNK * 512 * 4;
constexpr size_t WS_Z = WS_VB + (size_t)MT * DM * 2;
constexpr size_t WS_HS = WS_Z + (size_t)MT * ZW * 2;
constexpr size_t WS_END = WS_HS + (size_t)MS * DFF * 2;
constexpr size_t OUT_SP = (size_t)MT * DM, OUT_SS = OUT_SP + (size_t)DEPTH * NBATCH * 4 * 128 * 256, OUT_VN = OUT_SS + (size_t)DEPTH * DBATCH * 4 * 128 * 256;
constexpr size_t OUT_END = OUT_VN + (size_t)DEPTH * DBATCH * DSEQ * 512;
constexpr int LDS_BYTES = 147456;

struct Params { const float* in[19]; float* out; unsigned char* ws; };
enum { I_XP = 0, I_XS, I_STATE, I_LNG, I_LNB, I_W1, I_W3, I_W2, I_WIN, I_GMG, I_GMB, I_GMWS, I_GMBS, I_WA2, I_BA, I_GNG, I_WPA, I_WPB, I_WO };

__device__ __forceinline__ unsigned f2bf(float f) { unsigned u = __float_as_uint(f); return (u + 0x7fffu + ((u >> 16) & 1u)) >> 16; }
__device__ __forceinline__ float bf2f(unsigned h) { return __uint_as_float(h << 16); }
__device__ __forceinline__ float bflo(unsigned w) { return __uint_as_float(w << 16); }
__device__ __forceinline__ float bfhi(unsigned w) { return __uint_as_float(w & 0xffff0000u); }
__device__ __forceinline__ unsigned pk2(float lo, float hi) { return pg8::cvt_pk_bf16(lo, hi); }
__device__ __forceinline__ float sigmoidf_(float x) { return __builtin_amdgcn_rcpf(1.0f + __expf(-x)); }
constexpr float FXS = 65536.0f, FXS_INV = 1.0f / 65536.0f;
constexpr float FXQ = 4096.0f, FXQ_INV = 1.0f / 4096.0f;
__device__ __forceinline__ void fx_add(int* p, float v, float scale) { atomicAdd(p, (int)(v * scale)); }
__device__ __forceinline__ void row_stat(const int* st, int r, float& mu, float& rstd) {
    const int2 s = *(const int2*)(st + 2 * (size_t)r); mu = (float)s.x * (FXS_INV / DM); const float var = fmaxf((float)s.y * (FXQ_INV / DM) - mu * mu, 0.f); rstd = rsqrtf(var + LN_EPS);
}
typedef int i32x4 __attribute__((ext_vector_type(4)));
__device__ __forceinline__ f32x4 ld_cs4(const int* p) { const i32x4 v = *(const i32x4*)p; return (f32x4){(float)v.x, (float)v.y, (float)v.z, (float)v.w} * (1.0f / 16777216.0f); }
#define LDS_WAIT() asm volatile("s_waitcnt lgkmcnt(0)" ::: "memory")

struct EpiUp {
    static constexpr bool PERM = true, AFTER_DRAIN = false;
    bf16* H; const int* st; const int* cs; const int* cb;
    __device__ __forceinline__ void operator()(const f32x4 (&acc)[2][2][4][2], const pg8::Unit& u, int wr, int wc, int fr, int fq) const {
        const int row0 = u.pm * 256 + wr * 64 + fr, cidx = u.pn * 256 + wc * 32 + 8 * fq, hcol = u.pn * 128 + wc * 32 + 8 * fq;
        f32x4 s1[2], s3[2], b1[2], b3[2];
#pragma unroll
        for (int n = 0; n < 2; ++n) { s1[n] = ld_cs4(cs + cidx + 4 * n); s3[n] = ld_cs4(cs + cidx + 128 + 4 * n); b1[n] = ld_cs4(cb + cidx + 4 * n); b3[n] = ld_cs4(cb + cidx + 128 + 4 * n); }
#pragma unroll
        for (int ai = 0; ai < 2; ++ai)
#pragma unroll
            for (int m = 0; m < 4; ++m) {
                const int r = row0 + ai * 128 + m * 16; float mu, rstd; row_stat(st, r, mu, rstd);
                f32x4 h[2];
#pragma unroll
                for (int n = 0; n < 2; ++n) {
                    const f32x4 a1 = (acc[ai][0][m][n] - mu * s1[n]) * rstd + b1[n], a3 = (acc[ai][1][m][n] - mu * s3[n]) * rstd + b3[n];
#pragma unroll
                    for (int j = 0; j < 4; ++j) h[n][j] = a1[j] * sigmoidf_(a1[j]) * a3[j];
                }
                u32x4 w; w.x = pk2(h[0][0], h[0][1]); w.y = pk2(h[0][2], h[0][3]); w.z = pk2(h[1][0], h[1][1]); w.w = pk2(h[1][2], h[1][3]);
                *(u32x4*)(H + (size_t)r * DFF + hcol) = w;
                if (m & 1) asm volatile("" ::: "memory");
            }
    }
};
struct EpiZ {
    static constexpr bool PERM = true, AFTER_DRAIN = false;
    bf16* Z; const int* st; const int* cs; const int* cb; int* gst; float* glr;
    template <bool STAT> __device__ __forceinline__ void body(const f32x4 (&acc)[2][2][4][2], const pg8::Unit& u, int wr, int wc, int fr, int fq) const {
        const int row0 = u.pm * 256 + wr * 64 + fr, col0 = u.pn * 256 + wc * 32 + 8 * fq, pn = u.pn;
        const int kind = pn < 4 ? 0 : pn < 12 ? 1 : pn < 16 ? 2 : pn < 24 ? 3 : 4;
        const int zld = pn < 8 ? 512 : 1024;
        f32x4 sv[2][2], bv[2][2];
#pragma unroll
        for (int bj = 0; bj < 2; ++bj)
#pragma unroll
            for (int n = 0; n < 2; ++n) { sv[bj][n] = ld_cs4(cs + col0 + bj * 128 + 4 * n); bv[bj][n] = ld_cs4(cb + col0 + bj * 128 + 4 * n); }
        bf16* zg = Z + (pn < 8 ? (size_t)(pn >> 1) * MT * 512 + (pn & 1) * 256 : (size_t)MT * 2048 + (size_t)((pn - 8) >> 2) * MT * 1024 + ((pn - 8) & 3) * 256) + wc * 32 + 8 * fq;
#pragma unroll
        for (int ai = 0; ai < 2; ++ai)
#pragma unroll
            for (int m = 0; m < 4; ++m) {
                const int r = row0 + ai * 128 + m * 16; float mu, rstd; row_stat(st, r, mu, rstd);
                float s = 0.f, ss = 0.f;
#pragma unroll
                for (int bj = 0; bj < 2; ++bj) {
                    f32x4 v[2];
#pragma unroll
                    for (int n = 0; n < 2; ++n) {
                        v[n] = (acc[ai][bj][m][n] - mu * sv[bj][n]) * rstd + bv[bj][n];
                        if (kind == 0) { const f32x2 a = pg8::gelu_pk((f32x2){v[n][0], v[n][1]}), b = pg8::gelu_pk((f32x2){v[n][2], v[n][3]}); v[n] = (f32x4){a.x, a.y, b.x, b.y}; }
                        else if (kind == 2) {
#pragma unroll
                            for (int j = 0; j < 4; ++j) v[n][j] = v[n][j] * sigmoidf_(v[n][j]); }
                        else if (kind == 3) {
#pragma unroll
                            for (int j = 0; j < 4; ++j) v[n][j] = sigmoidf_(v[n][j]); }
                        if (STAT) { s += (v[n][0] + v[n][1]) + (v[n][2] + v[n][3]); ss += (v[n][0] * v[n][0] + v[n][1] * v[n][1]) + (v[n][2] * v[n][2] + v[n][3] * v[n][3]); }
                    }
                    if (kind != 4) { u32x4 w; w.x = pk2(v[0][0], v[0][1]); w.y = pk2(v[0][2], v[0][3]); w.z = pk2(v[1][0], v[1][1]); w.w = pk2(v[1][2], v[1][3]);
                        *(u32x4*)(zg + (size_t)r * zld + bj * 128) = w; }
                    else if (bj == 0 && wc == 0 && fq < 2) { *(f32x4*)(glr + (size_t)r * 16 + 8 * fq) = v[0]; *(f32x4*)(glr + (size_t)r * 16 + 8 * fq + 4) = v[1]; }
                }
                if (STAT) { s += __shfl_xor(s, 16); s += __shfl_xor(s, 32); ss += __shfl_xor(ss, 16); ss += __shfl_xor(ss, 32);
                    if (fq == 0) { fx_add(gst + 2 * (size_t)r, s, FXS); fx_add(gst + 2 * (size_t)r + 1, ss, FXQ); } }
                asm volatile("" ::: "memory");
            }
    }
    __device__ __forceinline__ void operator()(const f32x4 (&acc)[2][2][4][2], const pg8::Unit& u, int wr, int wc, int fr, int fq) const {
        if (u.pn == 2 || u.pn == 3) body<true>(acc, u, wr, wc, fr, fq); else body<false>(acc, u, wr, wc, fr, fq);
    }
};
struct EpiRes {
    static constexpr bool PERM = true, AFTER_DRAIN = false;
    const float* Vin; float* V; bf16* VB; const int* st_in; const float* g_in; const float* b_in; int* st_out; float ascale;
    __device__ __forceinline__ void operator()(const f32x4 (&acc)[2][2][4][2], const pg8::Unit& u, int wr, int wc, int fr, int fq) const {
        const int row0 = u.pm * 256 + wr * 64 + fr, col0 = u.pn * 256 + wc * 32 + 8 * fq;
        f32x4 gv[2][2], bv[2][2];
#pragma unroll
        for (int bj = 0; bj < 2; ++bj)
#pragma unroll
            for (int n = 0; n < 2; ++n) { gv[bj][n] = *(const f32x4*)(g_in + col0 + bj * 128 + 4 * n) * ALPHA; bv[bj][n] = *(const f32x4*)(b_in + col0 + bj * 128 + 4 * n) * ALPHA; }
#pragma unroll
        for (int ai = 0; ai < 2; ++ai)
#pragma unroll
            for (int m = 0; m < 4; ++m) {
                const int r = row0 + ai * 128 + m * 16; float mu, rstd; row_stat(st_in, r, mu, rstd);
                float s = 0.f, ss = 0.f; float* vp = V + (size_t)r * DM + col0; bf16* vbp = VB + (size_t)r * DM + col0;
#pragma unroll
                for (int bj = 0; bj < 2; ++bj) {
                    f32x4 o[2];
#pragma unroll
                    for (int n = 0; n < 2; ++n) {
                        const f32x4 vin = *(const f32x4*)(Vin + (size_t)r * DM + col0 + bj * 128 + 4 * n);
                        o[n] = ((vin - mu) * rstd) * gv[bj][n] + (bv[bj][n] + acc[ai][bj][m][n] * ascale);
                        *(f32x4*)(vp + bj * 128 + 4 * n) = o[n];
                        s += (o[n][0] + o[n][1]) + (o[n][2] + o[n][3]); ss += (o[n][0] * o[n][0] + o[n][1] * o[n][1]) + (o[n][2] * o[n][2] + o[n][3] * o[n][3]);
                    }
                    u32x4 w; w.x = pk2(o[0][0], o[0][1]); w.y = pk2(o[0][2], o[0][3]); w.z = pk2(o[1][0], o[1][1]); w.w = pk2(o[1][2], o[1][3]);
                    *(u32x4*)(vbp + bj * 128) = w;
                }
                s += __shfl_xor(s, 16); s += __shfl_xor(s, 32); ss += __shfl_xor(ss, 16); ss += __shfl_xor(ss, 32);
                if (fq == 0) { fx_add(st_out + 2 * (size_t)r, s, FXS); fx_add(st_out + 2 * (size_t)r + 1, ss, FXQ); }
                asm volatile("" ::: "memory");
            }
    }
};
template <bool SECOND> struct EpiGate {
    static constexpr bool PERM = true, AFTER_DRAIN = false;
    bf16* Z;
    __device__ __forceinline__ void operator()(const f32x4 (&acc)[2][2][4][2], const pg8::Unit& u, int wr, int wc, int fr, int fq) const {
        const int row0 = u.pm * 256 + wr * 64 + fr, col0 = u.pn * 256 + wc * 32 + 8 * fq;
#pragma unroll
        for (int ai = 0; ai < 2; ++ai)
#pragma unroll
            for (int m = 0; m < 4; ++m) {
                bf16* zr = Z + (size_t)(row0 + ai * 128 + m * 16) * 1024 + col0;
#pragma unroll
                for (int bj = 0; bj < 2; ++bj) {
                    bf16* pg = zr + (SECOND ? OZ_GB : OZ_GA) + bj * 128;
                    const u32x4 g = *(const u32x4*)pg; u32x4 t = (u32x4){0u, 0u, 0u, 0u};
                    if (SECOND) t = *(const u32x4*)(zr + OZ_GA + bj * 128);
                    const f32x4 a0 = acc[ai][bj][m][0], a1 = acc[ai][bj][m][1];
                    u32x4 w;
                    w.x = pk2(bflo(t.x) + bflo(g.x) * a0[0], bfhi(t.x) + bfhi(g.x) * a0[1]);
                    w.y = pk2(bflo(t.y) + bflo(g.y) * a0[2], bfhi(t.y) + bfhi(g.y) * a0[3]);
                    w.z = pk2(bflo(t.z) + bflo(g.z) * a1[0], bfhi(t.z) + bfhi(g.z) * a1[1]);
                    w.w = pk2(bflo(t.w) + bflo(g.w) * a1[2], bfhi(t.w) + bfhi(g.w) * a1[3]);
                    *(u32x4*)pg = w;
                }
                asm volatile("" ::: "memory");
            }
    }
};

constexpr float FXC = 16777216.0f, FXC_INV = 1.0f / 16777216.0f;
__device__ __forceinline__ void conv_item(const float* W, int ldw, int src_c0, int nvalid, int k0, bf16* WT, int K, int dst_n0,
                                          const float* g, const float* b, float scale, int* cs, int* cb, LAS float* scr, int lane) {
    const float* wp = W + (size_t)k0 * ldw + src_c0 + lane;
    const bool ok = lane < nvalid;
    float sc = 0.f, sb = 0.f;
#pragma unroll
    for (int hb = 0; hb < 2; ++hb) {
        float w[32];
#pragma unroll
        for (int i = 0; i < 32; ++i) w[i] = ok ? wp[(size_t)(32 * hb + i) * ldw] : 0.f;
#pragma unroll
        for (int i = 0; i < 32; ++i) { const int kk = 32 * hb + i; const float ws_ = w[i] * scale; const float gk = g ? g[k0 + kk] : 1.f, bk = b ? b[k0 + kk] : 0.f;
            const float wf = bf2f(f2bf(ws_ * gk)); scr[kk * 65 + lane] = wf; sc += wf; sb += ws_ * bk; }
        asm volatile("" ::: "memory");
    }
    if (cs) { atomicAdd(cs + dst_n0 + lane, (int)(sc * FXC)); atomicAdd(cb + dst_n0 + lane, (int)(sb * FXC)); }
    LDS_WAIT();
    const int c = lane & 7;
#pragma unroll
    for (int j = 0; j < 8; ++j) { const int nn = (lane >> 3) + 8 * j; const LAS float* s = scr + (8 * c) * 65 + nn;
        u32x4 o;
        o.x = (__float_as_uint(s[0 * 65]) >> 16) | (__float_as_uint(s[1 * 65]) & 0xffff0000u); o.y = (__float_as_uint(s[2 * 65]) >> 16) | (__float_as_uint(s[3 * 65]) & 0xffff0000u);
        o.z = (__float_as_uint(s[4 * 65]) >> 16) | (__float_as_uint(s[5 * 65]) & 0xffff0000u); o.w = (__float_as_uint(s[6 * 65]) >> 16) | (__float_as_uint(s[7 * 65]) & 0xffff0000u);
        *(u32x4*)(WT + (size_t)(dst_n0 + nn) * K + k0 + 8 * c) = o; }
    LDS_WAIT();
}
__device__ __forceinline__ void convert_phase(const Params& P, int l, LAS unsigned char* lds) {
    int tid = threadIdx.x; asm volatile("" : "+v"(tid));
    const int lane = tid & 63, wave = __builtin_amdgcn_readfirstlane(tid >> 6), G = gridDim.x;
    LAS float* scr = (LAS float*)(lds + wave * 16640);
    unsigned char* ws = P.ws;
    const float* lng = P.in[I_LNG]; const float* lnb = P.in[I_LNB];
    int* cscb = (int*)(ws + WS_CSCB) + (size_t)l * CSCB_L;
    int *cs13a = cscb, *cb13a = cscb + NUP, *csin = cscb + 2 * NUP, *cbin = csin + NIN, *cs13b = cbin + NIN, *cb13b = cs13b + NUP;
    const int gw = blockIdx.x * 8 + wave, NGW = G * 8;
    constexpr int I_UP = 16 * 44, I_DN = 44 * 16, I_IN = 16 * 100, I_PA = 8 * 16, I_PB = 16 * 16;
    constexpr int NITEMS = 4 * I_UP + 2 * I_DN + I_IN + I_PA + 2 * I_PB;
    for (int it = gw; it < NITEMS; it += NGW) {
        int r = it;
        if (r < 4 * I_UP) {
            const int sub = r / I_UP; r -= sub * I_UP; const int kb = r / 44, nb = r % 44, which = sub >> 1;
            const float* W = ((sub & 1) ? P.in[I_W3] : P.in[I_W1]) + (size_t)(l * 2 + which) * DM * DFF;
            const int c0 = nb * 64, dst = (c0 >> 7) * 256 + (sub & 1) * 128 + (c0 & 127);
            const float *g = nullptr, *b = nullptr;
            if (which == 1) { g = lng + (l * 3 + 1) * DM; b = lnb + (l * 3 + 1) * DM; } else if (l > 0) { g = lng + ((l - 1) * 3 + 2) * DM; b = lnb + ((l - 1) * 3 + 2) * DM; }
            conv_item(W, DFF, c0, 64, kb * 64, (bf16*)(ws + (which ? WS_W13B : WS_W13A)), DM, dst, g, b, 1.f, which ? cs13b : cs13a, which ? cb13b : cb13a, scr, lane);
            continue; }
        r -= 4 * I_UP;
        if (r < 2 * I_DN) { const int which = r / I_DN; r -= which * I_DN; const int kb = r / 16, nb = r % 16;
            conv_item(P.in[I_W2] + (size_t)(l * 2 + which) * DFF * DM, DM, nb * 64, 64, kb * 64, (bf16*)(ws + (which ? WS_W2B : WS_W2A)), DFF, nb * 64, nullptr, nullptr, 1.f, nullptr, nullptr, scr, lane);
            continue; }
        r -= 2 * I_DN;
        if (r < I_IN) { const int kb = r / 100, nb = r % 100, dst = nb * 64;
            int src = dst, nv = 64; float scale = 1.f;
            if (dst >= 4096 && dst < 6144) src = dst + 16; else if (dst == 6144) { src = 4096; nv = 16; } else if (dst > 6144) { src = 0; nv = 0; }
            if (dst >= ZQ && dst < ZK) scale = 0.08838834764831845f;
            conv_item(P.in[I_WIN] + (size_t)l * DM * INC, INC, src, nv, kb * 64, (bf16*)(ws + WS_WIN), DM, dst, lng + (l * 3) * DM, lnb + (l * 3) * DM, scale, csin, cbin, scr, lane);
            continue; }
        r -= I_IN;
        if (r < I_PA) { const int kb = r / 16, nb = r % 16;
            conv_item(P.in[I_WPA] + (size_t)l * 512 * DM, DM, nb * 64, 64, kb * 64, (bf16*)(ws + WS_WPA), 512, nb * 64, nullptr, nullptr, 1.f, nullptr, nullptr, scr, lane); continue; }
        r -= I_PA;
        { const int which = r / I_PB; r -= which * I_PB; const int kb = r / 16, nb = r % 16;
            conv_item((which ? P.in[I_WO] : P.in[I_WPB]) + (size_t)l * DM * DM, DM, nb * 64, 64, kb * 64, (bf16*)(ws + (which ? WS_WO : WS_WPB)), DM, nb * 64, nullptr, nullptr, 1.f, nullptr, nullptr, scr, lane); }
    }
    { const float* wsrc = P.in[I_GMWS] + (size_t)l * 65536; bf16* wd = (bf16*)(ws + WS_WSB);
      for (int i = blockIdx.x * 512 + tid; i < 65536; i += G * 512) { const int t = (i >> 7) & 127, s = i & 127; wd[i] = (bf16)(t >= s ? f2bf(wsrc[i]) : 0u); } }
    if (l == 0) {
        float* V = P.out; bf16* VB = (bf16*)(ws + WS_VB); int* st0 = (int*)(ws + WS_STATS);
        for (int m = gw; m < MT; m += NGW) {
            const float* xr = (m < MP) ? P.in[I_XP] + (size_t)m * DM : P.in[I_XS] + (size_t)(m - MP) * DM;
#pragma unroll
            for (int j = 0; j < 4; ++j) { const f32x4 v = *(const f32x4*)(xr + 4 * lane + 256 * j); if (G != 256) *(f32x4*)(V + (size_t)m * DM + 4 * lane + 256 * j) = v;
                u32x2 w; w.x = pk2(v[0], v[1]); w.y = pk2(v[2], v[3]); *(u32x2*)(VB + (size_t)m * DM + 4 * lane + 256 * j) = w; }
            if (lane == 0) { int idq = (int)((float)DM * (1.0f - LN_EPS) * FXQ); asm volatile("" : "+v"(idq));
                st0[2 * m] = 0; st0[2 * m + 1] = idq; }
        }
        if (blockIdx.x == 0) { float* o = (float*)(ws + WS_ONES); for (int i = tid; i < 2048; i += 512) o[i] = i < 1024 ? 1.f : 0.f; }
    }
}

__device__ __forceinline__ void prep_item(const Params& P, int l, int ci, LAS unsigned char* lds) {
    int tid = threadIdx.x; asm volatile("" : "+v"(tid));
    const int cp = tid & 255, rh = tid >> 8;
    LAS float* glr_s = (LAS float*)lds; LAS f32x2* tot_s = (LAS f32x2*)(glr_s + 1024);
    const size_t r0 = (size_t)ci * 64;
    const float* glr = (const float*)(P.ws + WS_GLR) + r0 * 16;
    if (tid < 256) ((LAS f32x4*)glr_s)[tid] = ((const f32x4*)glr)[tid];
    f32x2 w[16];
#pragma unroll
    for (int j = 0; j < 16; ++j) w[j] = *(const f32x2*)(P.in[I_WA2] + (size_t)(l * 16 + j) * 512 + 2 * cp);
    const f32x2 bias = *(const f32x2*)(P.in[I_BA] + l * 512 + 2 * cp);
    bf16* Z = (bf16*)(P.ws + WS_Z);
    unsigned* zq = (unsigned*)(Z + OZ_Q + (r0 + rh * 32) * 512 + 2 * cp); unsigned* zk = (unsigned*)(Z + OZ_K + (r0 + rh * 32) * 512 + 2 * cp);
    __syncthreads();
    f32x2 lg[32];
#pragma unroll
    for (int i = 0; i < 32; ++i) { const LAS f32x4* gr = (const LAS f32x4*)(glr_s + (rh * 32 + i) * 16); f32x2 x = bias;
#pragma unroll
        for (int q = 0; q < 4; ++q) { const f32x4 g4 = gr[q]; x += g4[0] * w[4 * q] + g4[1] * w[4 * q + 1] + g4[2] * w[4 * q + 2] + g4[3] * w[4 * q + 3]; }
        lg[i].x = (fminf(x.x, 0.f) - __logf(1.0f + __expf(-fabsf(x.x)))) * (1.0f / 16.0f);
        lg[i].y = (fminf(x.y, 0.f) - __logf(1.0f + __expf(-fabsf(x.y)))) * (1.0f / 16.0f); }
#pragma unroll
    for (int i = 1; i < 32; ++i) lg[i] += lg[i - 1];
    tot_s[rh * 256 + cp] = lg[31];
    __syncthreads();
    const f32x2 t0 = tot_s[cp], t1 = tot_s[256 + cp];
    const f32x2 off = rh ? t0 : (f32x2){0.f, 0.f}, total = t0 + t1;
#pragma unroll
    for (int bt = 0; bt < 4; ++bt) {
        unsigned qv[8], kv[8];
#pragma unroll
        for (int i = 0; i < 8; ++i) { qv[i] = zq[(size_t)(8 * bt + i) * 256]; kv[i] = zk[(size_t)(8 * bt + i) * 256]; }
#pragma unroll
        for (int i = 0; i < 8; ++i) { const f32x2 b = lg[8 * bt + i] + off;
            zq[(size_t)(8 * bt + i) * 256] = pk2(bflo(qv[i]) * __expf(b.x), bfhi(qv[i]) * __expf(b.y)); zk[(size_t)(8 * bt + i) * 256] = pk2(bflo(kv[i]) * __expf(-b.x), bfhi(kv[i]) * __expf(-b.y)); }
    }
    if (rh == 0) *(f32x2*)((float*)(P.ws + WS_DEC) + (size_t)ci * 512 + 2 * cp) = (f32x2){__expf(total.x), __expf(total.y)};
    __syncthreads();
}

typedef short s16x4 __attribute__((ext_vector_type(4)));
__device__ __forceinline__ bf16x8 tr_frag(const LAS bf16* tile, int pitch, int k0, int n0, int lane) {
    const int fq = lane >> 4, q = (lane & 15) >> 2, p = lane & 3;
    const LAS bf16* a = tile + (k0 + 8 * fq + q) * pitch + n0 + 4 * p;
    const s16x4 lo = __builtin_amdgcn_ds_read_tr16_b64_v4i16((LAS s16x4*)a), hi = __builtin_amdgcn_ds_read_tr16_b64_v4i16((LAS s16x4*)(a + 4 * pitch));
    return (bf16x8){lo.x, lo.y, lo.z, lo.w, hi.x, hi.y, hi.z, hi.w};
}

__device__ __forceinline__ void gmlp_item(const Params& P, int l, int it, LAS unsigned char* lds) {
    int tid = threadIdx.x; asm volatile("" : "+v"(tid));
    const int w = tid >> 6, lane = tid & 63, fr = lane & 15, fq = lane >> 4;
    const int cidx = it >> 2, g = it & 3;
    const bool samp = cidx >= 256; const int nrows = samp ? 64 : 128; const size_t r0 = samp ? (size_t)MP + (size_t)(cidx - 256) * 64 : (size_t)cidx * 128;
    constexpr int VP = 144;
    LAS bf16* vn_s = (LAS bf16*)lds;
    bf16* Z = (bf16*)(P.ws + WS_Z); const int* gst = (const int*)(P.ws + WS_GST) + (size_t)l * MT * 2;
    const float* gmg = P.in[I_GMG] + l * 512 + g * 128; const float* gmb = P.in[I_GMB] + l * 512 + g * 128;
    { const int seg = tid & 15; f32x4 g0 = *(const f32x4*)(gmg + seg * 8), g1 = *(const f32x4*)(gmg + seg * 8 + 4), b0 = *(const f32x4*)(gmb + seg * 8), b1 = *(const f32x4*)(gmb + seg * 8 + 4);
#pragma unroll
      for (int i = 0; i < 4; ++i) { const int row = (tid >> 4) + 32 * i; float vn[8];
        if (row < nrows) { const u32x4 raw = *(const u32x4*)(Z + OZ_V + (r0 + row) * 512 + g * 128 + seg * 8);
            const int2 s = *(const int2*)(gst + 2 * (r0 + row)); const float mu = (float)s.x * (FXS_INV / 512.0f), rstd = rsqrtf(fmaxf((float)s.y * (FXQ_INV / 512.0f) - mu * mu, 0.f) + LN_EPS);
            vn[0] = (bflo(raw.x) - mu) * rstd * g0[0] + b0[0]; vn[1] = (bfhi(raw.x) - mu) * rstd * g0[1] + b0[1]; vn[2] = (bflo(raw.y) - mu) * rstd * g0[2] + b0[2]; vn[3] = (bfhi(raw.y) - mu) * rstd * g0[3] + b0[3];
            vn[4] = (bflo(raw.z) - mu) * rstd * g1[0] + b1[0]; vn[5] = (bfhi(raw.z) - mu) * rstd * g1[1] + b1[1]; vn[6] = (bflo(raw.w) - mu) * rstd * g1[2] + b1[2]; vn[7] = (bfhi(raw.w) - mu) * rstd * g1[3] + b1[3];
            if (samp) { float* vo = P.out + OUT_VN + ((size_t)(l * DBATCH + (cidx - 256)) * DSEQ + row) * 512 + g * 128 + seg * 8;
                *(f32x4*)vo = (f32x4){vn[0], vn[1], vn[2], vn[3]}; *(f32x4*)(vo + 4) = (f32x4){vn[4], vn[5], vn[6], vn[7]}; }
        } else {
#pragma unroll
            for (int e = 0; e < 8; ++e) vn[e] = 0.f; }
        u32x4 pw; pw.x = pk2(vn[0], vn[1]); pw.y = pk2(vn[2], vn[3]); pw.z = pk2(vn[4], vn[5]); pw.w = pk2(vn[6], vn[7]);
        *(LAS u32x4*)(vn_s + row * VP + seg * 8) = pw;
      } }
    __syncthreads();
    if (16 * w < nrows) {
        const bf16* Wg = (const bf16*)(P.ws + WS_WSB) + (size_t)g * 16384 + (size_t)(16 * w + fr) * 128 + 8 * fq;
        const int nks = ((16 * w + 15) >> 5) + 1;
        bf16x8 fa[4];
#pragma unroll
        for (int ks = 0; ks < 4; ++ks) fa[ks] = (ks < nks) ? *(const bf16x8*)(Wg + 32 * ks) : (bf16x8){0, 0, 0, 0, 0, 0, 0, 0};
        const size_t rr = r0 + 16 * w + fr; const float bsv = P.in[I_GMBS][(size_t)(l * 4 + g) * 128 + 16 * w + fr];
#pragma unroll
        for (int dt = 0; dt < 8; ++dt) {
            f32x4 a = (f32x4){0.f, 0.f, 0.f, 0.f};
#pragma unroll
            for (int ks = 0; ks < 4; ++ks) if (ks < nks) { const bf16x8 fv = tr_frag(vn_s, VP, 32 * ks, 16 * dt, lane); a = __builtin_amdgcn_mfma_f32_16x16x32_bf16(fv, fa[ks], a, 0, 0, 0); }
            bf16* up = Z + OZ_U + rr * 512 + g * 128 + 16 * dt + 4 * fq; const u32x2 uu = *(const u32x2*)up;
            u32x2 o; o.x = pk2(bflo(uu.x) * (a[0] + bsv), bfhi(uu.x) * (a[1] + bsv)); o.y = pk2(bflo(uu.y) * (a[2] + bsv), bfhi(uu.y) * (a[3] + bsv));
            *(u32x2*)up = o;
        }
    }
    __syncthreads();
}

__device__ __forceinline__ void scan_item(const Params& P, int l, int sidx, int h, LAS unsigned char* lds) {
    int tid = threadIdx.x; asm volatile("" : "+v"(tid));
    const int w = tid >> 6, lane = tid & 63, fr = lane & 15, fq = lane >> 4;
    const bool samp = sidx >= NBATCH; const int nch = samp ? 1 : SEQ / 64; const int c0 = samp ? (MP / 64 + (sidx - NBATCH)) : sidx * (SEQ / 64);
    constexpr int QP = 136, KP = 144, VPT = 272, TP = 72;
    LAS bf16* qe_s = (LAS bf16*)lds;
    LAS bf16* ke_s = qe_s + 64 * QP;
    LAS bf16* v_s = ke_s + 64 * KP;
    LAS bf16* att_s = v_s + 64 * VPT;
    LAS float* dec_s = (LAS float*)(att_s + 64 * TP);
    LAS float* red_s = dec_s + 128;
    bf16* Z = (bf16*)(P.ws + WS_Z); const float* DEC = (const float*)(P.ws + WS_DEC);
    f32x4 S[2][8];
    if (samp) { const float* S0 = P.in[I_STATE] + ((size_t)(l * DBATCH + (sidx - NBATCH)) * 4 + h) * 32768;
        const float* sp = S0 + (size_t)(4 * fq) * 256 + 32 * w + fr;
#pragma unroll
        for (int kt = 0; kt < 8; ++kt) {
#pragma unroll
            for (int d = 0; d < 2; ++d)
#pragma unroll
                for (int j = 0; j < 4; ++j) S[d][kt][j] = sp[j * 256 + 16 * d];
            sp += 16 * 256; asm volatile("" : "+v"(sp) :: "memory"); }
    } else {
#pragma unroll
        for (int d = 0; d < 2; ++d)
#pragma unroll
            for (int kt = 0; kt < 8; ++kt) S[d][kt] = (f32x4){0.f, 0.f, 0.f, 0.f}; }
    const float* gnp = P.in[I_GNG] + l * 256 + 32 * w + 4 * fq;
    u32x4 qv[2], kv[2], vv[4]; float dcv = 0.f;
    const int seg16 = tid & 15, rowq = tid >> 4, seg32 = tid & 31, rowv = tid >> 5;
#define SCAN_LOAD_QK(ci) do { const size_t rb = (size_t)(ci) * 64; \
        _Pragma("unroll") for (int i = 0; i < 2; ++i) { const bf16* p = Z + (rb + rowq + 32 * i) * 512 + h * 128 + seg16 * 8; qv[i] = *(const u32x4*)(p + OZ_Q); kv[i] = *(const u32x4*)(p + OZ_K); } \
        if (tid < 128) dcv = DEC[((size_t)(ci) * 4 + h) * 128 + tid]; } while (0)
#define SCAN_LOAD_V(ci) do { const size_t rb = (size_t)(ci) * 64; \
        _Pragma("unroll") for (int i = 0; i < 4; ++i) vv[i] = *(const u32x4*)(Z + OZ_VG + (rb + rowv + 16 * i) * 1024 + h * 256 + seg32 * 8); } while (0)
    SCAN_LOAD_QK(c0); SCAN_LOAD_V(c0);
    for (int n = 0; n < nch; ++n) {
        const size_t r0 = (size_t)(c0 + n) * 64;
#pragma unroll
        for (int i = 0; i < 2; ++i) { const int row = rowq + 32 * i;
            *(LAS u32x4*)(qe_s + row * QP + seg16 * 8) = qv[i]; *(LAS u32x4*)(ke_s + row * KP + seg16 * 8) = kv[i]; }
#pragma unroll
        for (int i = 0; i < 4; ++i) *(LAS u32x4*)(v_s + (rowv + 16 * i) * VPT + seg32 * 8) = vv[i];
        if (tid < 128) dec_s[tid] = dcv;
        __syncthreads();
        if (n + 1 < nch) { SCAN_LOAD_QK(c0 + n + 1); SCAN_LOAD_V(c0 + n + 1); }
        __builtin_amdgcn_sched_barrier(0);
        { const int tt = w >> 1;
#pragma unroll
          for (int si = 0; si < 2; ++si) { const int st = 2 * (w & 1) + si; f32x4 a = (f32x4){0.f, 0.f, 0.f, 0.f};
            if (st <= tt) {
#pragma unroll
                for (int ks = 0; ks < 4; ++ks) { const bf16x8 fk = *(const LAS bf16x8*)(ke_s + (16 * st + fr) * KP + 32 * ks + 8 * fq), fqv = *(const LAS bf16x8*)(qe_s + (16 * tt + fr) * QP + 32 * ks + 8 * fq);
                    a = __builtin_amdgcn_mfma_f32_16x16x32_bf16(fk, fqv, a, 0, 0, 0); }
#pragma unroll
                for (int j = 0; j < 4; ++j) if (16 * st + 4 * fq + j > 16 * tt + fr) a[j] = 0.f; }
            u32x2 o; o.x = pk2(a[0], a[1]); o.y = pk2(a[2], a[3]); *(LAS u32x2*)(att_s + (16 * tt + fr) * TP + 16 * st + 4 * fq) = o; } }
        __syncthreads();
        __builtin_amdgcn_sched_barrier(0);
        f32x4 O[4][2];
#pragma unroll
        for (int tt = 0; tt < 4; ++tt)
#pragma unroll
            for (int d = 0; d < 2; ++d) O[tt][d] = (f32x4){0.f, 0.f, 0.f, 0.f};
#pragma unroll
        for (int ks = 0; ks < 2; ++ks) { bf16x8 fv[2];
#pragma unroll
            for (int d = 0; d < 2; ++d) fv[d] = tr_frag(v_s, VPT, 32 * ks, 32 * w + 16 * d, lane);
#pragma unroll
            for (int tt = 0; tt < 4; ++tt) { const bf16x8 fa = *(const LAS bf16x8*)(att_s + (16 * tt + fr) * TP + 32 * ks + 8 * fq);
#pragma unroll
                for (int d = 0; d < 2; ++d) O[tt][d] = __builtin_amdgcn_mfma_f32_16x16x32_bf16(fv[d], fa, O[tt][d], 0, 0, 0); } }
        __builtin_amdgcn_sched_barrier(0);
#pragma unroll
        for (int ks = 0; ks < 4; ++ks) { bf16x8 fs[2];
#pragma unroll
            for (int d = 0; d < 2; ++d) { const f32x4 s0 = S[d][2 * ks], s1 = S[d][2 * ks + 1]; u32x4 pkd; pkd.x = pk2(s0[0], s0[1]); pkd.y = pk2(s0[2], s0[3]); pkd.z = pk2(s1[0], s1[1]); pkd.w = pk2(s1[2], s1[3]); fs[d] = __builtin_bit_cast(bf16x8, pkd); }
#pragma unroll
            for (int tt = 0; tt < 4; ++tt) { const LAS bf16* qp = qe_s + (16 * tt + fr) * QP + 32 * ks + 4 * fq; const u32x2 lo = *(const LAS u32x2*)qp, hi = *(const LAS u32x2*)(qp + 16);
                const bf16x8 fqp = __builtin_bit_cast(bf16x8, ((u32x4){lo.x, lo.y, hi.x, hi.y}));
#pragma unroll
                for (int d = 0; d < 2; ++d) O[tt][d] = __builtin_amdgcn_mfma_f32_16x16x32_bf16(fs[d], fqp, O[tt][d], 0, 0, 0); } }
        __builtin_amdgcn_sched_barrier(0);
        u32x2 ggv[4][2];
#pragma unroll
        for (int tt = 0; tt < 4; ++tt)
#pragma unroll
            for (int d = 0; d < 2; ++d) ggv[tt][d] = *(const u32x2*)(Z + OZ_GG + (r0 + 16 * tt + fr) * 1024 + h * 256 + 32 * w + 4 * fq + 16 * d);
        __builtin_amdgcn_sched_barrier(0);
#pragma unroll
        for (int ks = 0; ks < 2; ++ks) { bf16x8 fv[2];
#pragma unroll
            for (int d = 0; d < 2; ++d) fv[d] = tr_frag(v_s, VPT, 32 * ks, 32 * w + 16 * d, lane);
#pragma unroll
            for (int kt = 0; kt < 8; ++kt) { const bf16x8 fk = tr_frag(ke_s, KP, 32 * ks, 16 * kt, lane);
#pragma unroll
                for (int d = 0; d < 2; ++d) S[d][kt] = __builtin_amdgcn_mfma_f32_16x16x32_bf16(fk, fv[d], S[d][kt], 0, 0, 0); } }
#pragma unroll
        for (int kt = 0; kt < 8; ++kt) { const f32x4 dc = *(const LAS f32x4*)(dec_s + 16 * kt + 4 * fq);
#pragma unroll
            for (int d = 0; d < 2; ++d) S[d][kt] = S[d][kt] * dc; }
        __builtin_amdgcn_sched_barrier(0);
#pragma unroll
        for (int tt = 0; tt < 4; ++tt) { float ss = 0.f;
#pragma unroll
            for (int d = 0; d < 2; ++d) ss += (O[tt][d][0] * O[tt][d][0] + O[tt][d][1] * O[tt][d][1]) + (O[tt][d][2] * O[tt][d][2] + O[tt][d][3] * O[tt][d][3]);
            ss += __shfl_xor(ss, 16); ss += __shfl_xor(ss, 32);
            if (fq == 0) red_s[w * 64 + 16 * tt + fr] = ss; }
        __syncthreads();
#pragma unroll
        for (int tt = 0; tt < 4; ++tt) { float tot = 0.f;
#pragma unroll
            for (int q = 0; q < 8; ++q) tot += red_s[q * 64 + 16 * tt + fr];
            const float rstd = rsqrtf(tot * (1.0f / 256.0f) + LN_EPS);
            bf16* zr = Z + (r0 + 16 * tt + fr) * 1024 + h * 256 + 32 * w + 4 * fq;
#pragma unroll
            for (int d = 0; d < 2; ++d) { const u32x2 gg = ggv[tt][d]; const f32x4 o = O[tt][d] * rstd * *(const f32x4*)(gnp + 16 * d);
                u32x2 ow; ow.x = pk2(o[0] * bflo(gg.x), o[1] * bfhi(gg.x)); ow.y = pk2(o[2] * bflo(gg.y), o[3] * bfhi(gg.y));
                *(u32x2*)(zr + OZ_VG + 16 * d) = ow; } }
    }
#undef SCAN_LOAD_QK
#undef SCAN_LOAD_V
    float* So = samp ? P.out + OUT_SS + ((size_t)(l * DBATCH + (sidx - NBATCH)) * 4 + h) * 32768 : P.out + OUT_SP + ((size_t)(l * NBATCH + sidx) * 4 + h) * 32768;
    So += (size_t)(4 * fq) * 256 + 32 * w + fr;
#pragma unroll
    for (int kt = 0; kt < 8; ++kt) {
#pragma unroll
        for (int d = 0; d < 2; ++d)
#pragma unroll
            for (int j = 0; j < 4; ++j) So[j * 256 + 16 * d] = S[d][kt][j];
        So += 16 * 256; asm volatile("" : "+v"(So) :: "memory"); }
    __syncthreads();
}
#define XB_TMO      128
#define XB_XCNT(j)  (256  + 64 * (j))
#define XB_XSUB(j)  (1280 + 64 * (j))
#define XB_XGEN(j)  (2304 + 64 * (j))
#define XB_TOP      3328
#define XB_TOPGEN   3392
#define XCD_BAR_WORDS 3456
#define XB_SPIN_CAP (1u << 18)

__device__ __forceinline__ unsigned xb_ld(unsigned* p)              { return __hip_atomic_load(p, __ATOMIC_RELAXED, __HIP_MEMORY_SCOPE_AGENT); }
__device__ __forceinline__ unsigned xb_add(unsigned* p, unsigned v) { return __hip_atomic_fetch_add(p, v, __ATOMIC_RELAXED, __HIP_MEMORY_SCOPE_AGENT); }
__device__ __forceinline__ unsigned xb_xcc_id() { return (unsigned)__builtin_amdgcn_s_getreg((3 << 11) | 20) & 0xFu; }
#define XB_SPIN(cond, bar) do { unsigned _sp = 0; while (cond) { __builtin_amdgcn_s_sleep(1); \
    if ((++_sp & 255u) == 0u) { if (xb_ld(&(bar)[XB_TMO])) break; if (_sp > XB_SPIN_CAP) { atomicAdd(&(bar)[XB_TMO], 1u); break; } } } } while (0)

struct XcdBarrier {
    unsigned* bar; unsigned x;
    volatile LAS unsigned* st;
};

__device__ __forceinline__ XcdBarrier xcd_barrier_post(unsigned* bar, volatile LAS unsigned* st) {
    XcdBarrier b; b.bar = bar; b.x = xb_xcc_id(); b.st = st;
    if (threadIdx.x == 0) (void)xb_add(&bar[XB_XCNT(b.x)], 1u);
    return b;
}
__device__ __forceinline__ void xcd_barrier_complete(unsigned* bar, unsigned x, unsigned& nloc, unsigned& nx) {
    const unsigned G = gridDim.x * gridDim.y * gridDim.z;
    unsigned sum, cnt, mine, sp = 0u;
    for (;;) {
        sum = 0u; cnt = 0u; mine = 0u;
#pragma unroll
        for (unsigned j = 0; j < 16; ++j) { const unsigned c = xb_ld(&bar[XB_XCNT(j)]); sum += c; cnt += (c > 0u) ? 1u : 0u; mine = (j == x) ? c : mine; }
        if (sum == G) break;
        __builtin_amdgcn_s_sleep(1);
        if ((++sp & 255u) == 0u) { if (xb_ld(&bar[XB_TMO])) break; if (sp > XB_SPIN_CAP) { atomicAdd(&bar[XB_TMO], 1u); break; } }
    }
    nloc = mine > 0u ? mine : 1u; nx = cnt > 0u ? cnt : 1u;
}

__device__ __forceinline__ void xcd_barrier(const XcdBarrier& b) {
    asm volatile("s_waitcnt vmcnt(0)" ::: "memory");
    __syncthreads();
    if (threadIdx.x == 0) {
        unsigned* bar = b.bar;
        __builtin_amdgcn_s_waitcnt(0);
        unsigned nloc = b.st[0], nx = b.st[1];
        if (nloc == 0u) { xcd_barrier_complete(bar, b.x, nloc, nx); b.st[0] = nloc; b.st[1] = nx; }
        const unsigned old = xb_add(&bar[XB_XSUB(b.x)], 1u);
        const unsigned gen = old / nloc;
        if (old + 1u == (gen + 1u) * nloc) {
            __builtin_amdgcn_fence(__ATOMIC_RELEASE, "agent");
            asm volatile("s_waitcnt vmcnt(0)" ::: "memory");
            const unsigned og = xb_add(&bar[XB_TOP], 1u);
            const unsigned tg = og / nx;
            if (og + 1u == (tg + 1u) * nx) xb_add(&bar[XB_TOPGEN], 1u);
            else XB_SPIN(xb_ld(&bar[XB_TOPGEN]) == tg, bar);
            __builtin_amdgcn_fence(__ATOMIC_ACQUIRE, "agent");
            xb_add(&bar[XB_XGEN(b.x)], 1u);
            asm volatile("s_waitcnt vmcnt(0)" ::: "memory");
        } else {
            XB_SPIN(xb_ld(&bar[XB_XGEN(b.x)]) == gen, bar);
            __builtin_amdgcn_fence(__ATOMIC_ACQUIRE, "agent");
            asm volatile("s_waitcnt vmcnt(0)" ::: "memory");
        }
    }
    __syncthreads();
}

#ifndef GEMSEL
#define GEMSEL 255
#endif
#ifndef PHM
#define PHM 31
#endif
#if PHM & 8
#define SCAN_CALL scan_item
#else
#define SCAN_CALL(...) do {} while (0)
#endif
#if PHM & 16
#define GMLP_CALL gmlp_item
#else
#define GMLP_CALL(...) do {} while (0)
#endif
template <class Epi> __device__ __forceinline__ void run_gemm(LAS unsigned char* lds, const bf16* A, int lda, const bf16* Bt, int N, int K, const Epi& E, int M = MT, int G = -1, int c = -1) {
    if (G < 0) { G = (int)gridDim.x; c = (int)blockIdx.x; }
    pg8::Gemm g{A, Bt, lda, M, N, K}; pg8::StaticOrder S; S.init(M, N, G, c);
#if PHM & 2
    pg8::gemm_phase<Epi, pg8::StaticOrder, true, true>((PG8_LAS unsigned char*)lds, g, S, E);
#endif
}

struct WinOrder : pg8::StaticOrder {
    const unsigned* cntB;
    __device__ bool next(int i, pg8::Unit& u) const {
        const int skip = c < 8 ? 4 : c < 44 ? 1 : 0; const int ii = i + skip;
        int L;
        if (ii < 12) L = ii * 256 + c;
        else if (ii == 12) { if (c < 178) L = 12 * 256 + c; else { const int o = c - 178; if (o >= 68) return false; L = o < 32 ? (o & 3) * 256 + (o >> 2) : (o - 32 + 8); } }
        else return false;
        if (L >= nwg) return false;
        int wgid = L; { const int q = nwg / pg8::NXCD, r = nwg % pg8::NXCD, xcd = wgid % pg8::NXCD, off = wgid / pg8::NXCD; wgid = (xcd < r ? xcd * (q + 1) : r * (q + 1) + (xcd - r) * q) + off; }
        const int nig = pg8::WGM * nN, gid = wgid / nig, fm = gid * pg8::WGM, gsz = (nM - fm) < pg8::WGM ? (nM - fm) : pg8::WGM;
        u.pm = fm + ((wgid % nig) % gsz); u.pn = (wgid % nig) / gsz; return true;
    }
    __device__ __forceinline__ void a_ready(const pg8::Unit& u) const {
        if (u.pm >= MP / 256) {
            if (threadIdx.x < 64) { unsigned sp = 0;
                while ((unsigned)__builtin_amdgcn_readfirstlane(__hip_atomic_load(cntB, __ATOMIC_RELAXED, __HIP_MEMORY_SCOPE_AGENT)) < 8u) { __builtin_amdgcn_s_sleep(2); if (++sp > (1u << 22)) break; }
                __builtin_amdgcn_fence(__ATOMIC_ACQUIRE, "agent"); asm volatile("s_waitcnt vmcnt(0)" ::: "memory"); }
            asm volatile("" ::: "memory"); __builtin_amdgcn_s_barrier(); asm volatile("" ::: "memory");
        }
    }
};
__device__ __forceinline__ void wg_publish(unsigned* cnt) {
    asm volatile("s_waitcnt vmcnt(0) lgkmcnt(0)" ::: "memory"); __syncthreads();
    if (threadIdx.x == 0) { __builtin_amdgcn_fence(__ATOMIC_RELEASE, "agent"); asm volatile("s_waitcnt vmcnt(0)" ::: "memory"); (void)__hip_atomic_fetch_add(cnt, 1u, __ATOMIC_RELAXED, __HIP_MEMORY_SCOPE_AGENT); }
}
__device__ __forceinline__ void wg_wait(const unsigned* cnt, unsigned target) {
    if (threadIdx.x == 0) { unsigned sp = 0; while (__hip_atomic_load(cnt, __ATOMIC_RELAXED, __HIP_MEMORY_SCOPE_AGENT) < target) { __builtin_amdgcn_s_sleep(2); if (++sp > (1u << 22)) break; }
        __builtin_amdgcn_fence(__ATOMIC_ACQUIRE, "agent"); asm volatile("s_waitcnt vmcnt(0)" ::: "memory"); }
    __syncthreads();
}
__device__ __forceinline__ void sub_barrier(unsigned* cnt, unsigned target) {
    asm volatile("s_waitcnt vmcnt(0) lgkmcnt(0)" ::: "memory"); __syncthreads();
    if (threadIdx.x == 0) {
        __builtin_amdgcn_fence(__ATOMIC_RELEASE, "agent"); asm volatile("s_waitcnt vmcnt(0)" ::: "memory");
        (void)__hip_atomic_fetch_add(cnt, 1u, __ATOMIC_RELAXED, __HIP_MEMORY_SCOPE_AGENT);
        unsigned sp = 0; while (__hip_atomic_load(cnt, __ATOMIC_RELAXED, __HIP_MEMORY_SCOPE_AGENT) < target) { __builtin_amdgcn_s_sleep(1); if (++sp > (1u << 22)) break; }
        __builtin_amdgcn_fence(__ATOMIC_ACQUIRE, "agent"); asm volatile("s_waitcnt vmcnt(0)" ::: "memory");
    }
    __syncthreads();
}
constexpr int PTAB_OFF = 139264 + 64;
__device__ __forceinline__ const float* ptab_ld(LAS unsigned char* lds, int i) {
    unsigned base = PTAB_OFF; asm volatile("" : "+v"(base));
    const unsigned long long v = ((volatile LAS unsigned long long*)(lds + base))[i];
    const unsigned lo = __builtin_amdgcn_readfirstlane((unsigned)v), hi = __builtin_amdgcn_readfirstlane((unsigned)(v >> 32));
    return (const float*)(((unsigned long long)hi << 32) | lo);
}
__device__ __forceinline__ Params ptab_params(LAS unsigned char* lds) {
    Params Q;
    unsigned base = PTAB_OFF; asm volatile("" : "+v"(base));
    volatile LAS unsigned long long* tab = (volatile LAS unsigned long long*)(lds + base);
#pragma unroll
    for (int i = 0; i < 21; ++i) { const unsigned long long v = tab[i];
        const unsigned lo = __builtin_amdgcn_readfirstlane((unsigned)v), hi = __builtin_amdgcn_readfirstlane((unsigned)(v >> 32));
        const float* p = (const float*)(((unsigned long long)hi << 32) | lo);
        if (i < 19) Q.in[i] = p; else if (i == 19) Q.out = (float*)p; else Q.ws = (unsigned char*)p; }
    return Q;
}
#ifndef PROBE_MASK
#define PROBE_MASK 0
#endif
#ifndef PROBE_K
#define PROBE_K 1
#endif
__global__ void __launch_bounds__(512, 2) fwd_megakernel(Params P) {
    extern __shared__ __attribute__((aligned(16))) unsigned char lds_raw[];
    LAS unsigned char* lds = (LAS unsigned char*)lds_raw;
    cg::grid_group grid = cg::this_grid();
    volatile LAS unsigned* bar_st = (volatile LAS unsigned*)(lds + 139264);
    if (threadIdx.x < 4) bar_st[threadIdx.x] = 0u;
    if (threadIdx.x < 19) ((volatile LAS unsigned long long*)(lds + PTAB_OFF))[threadIdx.x] = (unsigned long long)P.in[threadIdx.x];
    if (threadIdx.x == 19) ((volatile LAS unsigned long long*)(lds + PTAB_OFF))[19] = (unsigned long long)P.out;
    if (threadIdx.x == 20) ((volatile LAS unsigned long long*)(lds + PTAB_OFF))[20] = (unsigned long long)P.ws;
    __syncthreads();
    { const XcdBarrier xb0 = xcd_barrier_post((unsigned*)(P.ws + WS_BAR), bar_st); if (threadIdx.x == 0) bar_st[2] = xb0.x; }
#define GRID_SYNC() do { XcdBarrier xb_; xb_.bar = (unsigned*)(ptab_ld(lds, 20)) + WS_BAR / 4; xb_.st = bar_st; xb_.x = (unsigned)__builtin_amdgcn_readfirstlane((int)bar_st[2]); xcd_barrier(xb_); } while (0)
#define GRID_SYNC_CG() do { asm volatile("s_waitcnt vmcnt(0) lgkmcnt(0)" ::: "memory"); grid.sync(); __builtin_amdgcn_fence(__ATOMIC_ACQUIRE, "agent"); asm volatile("s_waitcnt vmcnt(0)" ::: "memory"); } while (0)
    unsigned long long tprev = 0;
    if (PROBE_MASK) tprev = __builtin_amdgcn_s_memrealtime();
#define GSYNC(grp) do { GRID_SYNC(); if (PROBE_MASK) { if (PROBE_MASK & (grp)) { const unsigned long long now = __builtin_amdgcn_s_memrealtime(), until = now + (now - tprev) * PROBE_K; \
        while (__builtin_amdgcn_s_memrealtime() < until) __builtin_amdgcn_s_sleep(8); } tprev = __builtin_amdgcn_s_memrealtime(); } } while (0)
#define PHASE_PTRS() const Params Q = ptab_params(lds); unsigned char* ws = Q.ws; float* V = Q.out; bf16* VB = (bf16*)(ws + WS_VB); bf16* Z = (bf16*)(ws + WS_Z); bf16* H = Z; \
        int* stats = (int*)(ws + WS_STATS); const float* lng = Q.in[I_LNG]; const float* lnb = Q.in[I_LNB]; const float* ones = (const float*)(ws + WS_ONES); const float* zeros = ones + 1024; \
        int* cscb = (int*)(ws + WS_CSCB) + (size_t)l * CSCB_L; int *cs13a = cscb, *cb13a = cscb + NUP, *csin = cscb + 2 * NUP, *cbin = csin + NIN, *cs13b = cbin + NIN, *cb13b = cs13b + NUP; \
        int* st0 = stats + (size_t)(3 * l) * MT * 2; int* st1 = st0 + (size_t)MT * 2; int* st2 = st1 + (size_t)MT * 2; int* st3 = st2 + (size_t)MT * 2; \
        const float* g_prev = l ? lng + ((l - 1) * 3 + 2) * DM : ones; const float* b_prev = l ? lnb + ((l - 1) * 3 + 2) * DM : zeros; \
        (void)V; (void)VB; (void)Z; (void)H; (void)cs13a; (void)cb13a; (void)csin; (void)cbin; (void)cs13b; (void)cb13b; (void)st0; (void)st1; (void)st2; (void)st3; (void)g_prev; (void)b_prev
    for (int l = 0; l < DEPTH; ++l) {
#if PHM & 1
        { PHASE_PTRS(); convert_phase(Q, l, lds); }
#endif
        if (l == 0) { GRID_SYNC_CG(); if (PROBE_MASK) { if (PROBE_MASK & 128) { const unsigned long long now = __builtin_amdgcn_s_memrealtime(), until = now + (now - tprev) * PROBE_K; while (__builtin_amdgcn_s_memrealtime() < until) __builtin_amdgcn_s_sleep(8); } tprev = __builtin_amdgcn_s_memrealtime(); } } else GSYNC(1);
#ifdef PROBE_EXTRA_SYNCS
        for (int xs = 0; xs < PROBE_EXTRA_SYNCS; ++xs) GRID_SYNC();
#endif
        { PHASE_PTRS(); EpiUp E{H, st0, cs13a, cb13a}; if (GEMSEL & 1) run_gemm(lds, VB, DM, (const bf16*)(ws + WS_W13A), NUP, DM, E, gridDim.x == 256 ? MP : MT); }
        GSYNC(2);
        { PHASE_PTRS(); EpiRes E{(l == 0 && gridDim.x == 256) ? Q.in[I_XP] : V, V, VB, st0, g_prev, b_prev, st1, 0.5f}; if (GEMSEL & 2) run_gemm(lds, H, DFF, (const bf16*)(ws + WS_W2A), DM, DFF, E, gridDim.x == 256 ? MP : MT); }
        GSYNC(4);
        { PHASE_PTRS(); EpiZ E{Z, st1, csin, cbin, (int*)(ws + WS_GST) + (size_t)l * MT * 2, (float*)(ws + WS_GLR)};
          if (gridDim.x == 256) {
              unsigned* cntA = (unsigned*)(ws + WS_SUB) + (DEPTH + 2 * l) * 64; unsigned* cntB = cntA + 64; int bx = blockIdx.x; asm volatile("" : "+s"(bx));
              bf16* HS = (bf16*)(ws + WS_HS);
              if (bx < 44) { EpiUp EU{HS, st0 + 2 * MP, cs13a, cb13a}; run_gemm(lds, VB + (size_t)MP * DM, DM, (const bf16*)(ws + WS_W13A), NUP, DM, EU, MS, 44, bx); wg_publish(cntA); }
              if (bx < 8) { wg_wait(cntA, 44u);
                  EpiRes ER{l == 0 ? Q.in[I_XS] : V + (size_t)MP * DM, V + (size_t)MP * DM, VB + (size_t)MP * DM, st0 + 2 * MP, g_prev, b_prev, st1 + 2 * MP, 0.5f}; run_gemm(lds, HS, DFF, (const bf16*)(ws + WS_W2A), DM, DFF, ER, MS, 8, bx); wg_publish(cntB); }
              __syncthreads();
              pg8::Gemm g{VB, (const bf16*)(ws + WS_WIN), DM, MT, NIN, DM}; WinOrder S; S.init(MT, NIN, 256, bx); S.cntB = cntB;
              pg8::gemm_phase<EpiZ, WinOrder, true, true>((PG8_LAS unsigned char*)lds, g, S, E);
          } else if (GEMSEL & 4) run_gemm(lds, VB, DM, (const bf16*)(ws + WS_WIN), NIN, DM, E); }
        GSYNC(8);
#if PHM & 4
        { PHASE_PTRS(); for (int it = blockIdx.x; it < NCHUNK; it += gridDim.x) prep_item(Q, l, it, lds);
          if (blockIdx.x >= 224) GMLP_CALL(Q, l, 1024 + ((int)blockIdx.x - 224), lds); }
#endif
        GSYNC(16);
        { PHASE_PTRS(); const int G = gridDim.x, bx = blockIdx.x; const int nscan = (NBATCH + DBATCH) * 4;
          if (G == 256) {
            if (bx < nscan) SCAN_CALL(Q, l, bx >> 2, bx & 3, lds);
            else if (bx < 128) { if (bx < 104) { EpiGate<false> E{Z + (size_t)MP * 1024}; run_gemm(lds, Z + OZ_U + (size_t)MP * 512, 512, (const bf16*)(ws + WS_WPA), DM, 512, E, MS, 8, bx - 96); } }
            else {
                const int pj = bx - 128;
                for (int k = 0; k < 8; ++k) GMLP_CALL(Q, l, 8 * pj + k, lds);
                asm volatile("s_waitcnt vmcnt(0) lgkmcnt(0)" ::: "memory"); __syncthreads();
                __builtin_amdgcn_fence(__ATOMIC_ACQUIRE, "agent"); asm volatile("s_waitcnt vmcnt(0)" ::: "memory");
                { EpiGate<false> E{Z + (size_t)pj * 256 * 1024}; run_gemm(lds, Z + OZ_U + (size_t)pj * 256 * 512, 512, (const bf16*)(ws + WS_WPA), DM, 512, E, 256, 1, 0); }
            }
            if (bx >= 64 && bx < 128) {
                unsigned* hc = (unsigned*)(ws + WS_SUB) + (3 * DEPTH + 4 * l) * 64; const int c = bx - 64;
                bf16* HS = (bf16*)(ws + WS_HS); bf16* Zs = Z + (size_t)MP * 1024;
                if (bx < 104) wg_publish(hc);
                if (c < 8) { wg_wait(hc, 40u);
                { EpiGate<true> E{Zs}; run_gemm(lds, Zs + OZ_VG, DM, (const bf16*)(ws + WS_WPB), DM, DM, E, MS, 64, c); }
                wg_publish(hc + 64); wg_wait(hc + 64, 8u);
                { EpiRes E{V + (size_t)MP * DM, V + (size_t)MP * DM, VB + (size_t)MP * DM, st1 + 2 * MP, lng + (l * 3) * DM, lnb + (l * 3) * DM, st2 + 2 * MP, 1.0f}; run_gemm(lds, Zs + OZ_GB, DM, (const bf16*)(ws + WS_WO), DM, DM, E, MS, 64, c); }
                wg_publish(hc + 128); }
                if (c < 44) { wg_wait(hc + 128, 8u);
                { EpiUp E{HS, st2 + 2 * MP, cs13b, cb13b}; run_gemm(lds, VB + (size_t)MP * DM, DM, (const bf16*)(ws + WS_W13B), NUP, DM, E, MS, 64, c); }
                wg_publish(hc + 192); }
                if (c < 8) { wg_wait(hc + 192, 44u);
                { EpiRes E{V + (size_t)MP * DM, V + (size_t)MP * DM, VB + (size_t)MP * DM, st2 + 2 * MP, lng + (l * 3 + 1) * DM, lnb + (l * 3 + 1) * DM, st3 + 2 * MP, 0.5f}; run_gemm(lds, HS, DFF, (const bf16*)(ws + WS_W2B), DM, DFF, E, MS, 64, c); } }
            }
          } else { const int ns = G >= 2 * nscan ? nscan : G;
            if (G >= 2 * nscan) { if (bx < nscan) SCAN_CALL(Q, l, bx >> 2, bx & 3, lds); else for (int it = bx - nscan; it < (256 + DBATCH) * 4; it += G - nscan) GMLP_CALL(Q, l, it, lds); }
            else { for (int it = bx; it < nscan; it += ns) SCAN_CALL(Q, l, it >> 2, it & 3, lds); for (int it = bx; it < (256 + DBATCH) * 4; it += G) GMLP_CALL(Q, l, it, lds); } } }
        GSYNC(32);
        if (gridDim.x != 256) { { PHASE_PTRS(); EpiGate<false> E{Z}; if (GEMSEL & 8) run_gemm(lds, Z + OZ_U, 512, (const bf16*)(ws + WS_WPA), DM, 512, E, MT); }
        GSYNC(64); }
        { PHASE_PTRS(); EpiGate<true> E{Z}; if (GEMSEL & 16) run_gemm(lds, Z + OZ_VG, DM, (const bf16*)(ws + WS_WPB), DM, DM, E, gridDim.x == 256 ? MP : MT); }
        GSYNC(64);
        { PHASE_PTRS(); EpiRes E{V, V, VB, st1, lng + (l * 3) * DM, lnb + (l * 3) * DM, st2, 1.0f}; if (GEMSEL & 32) run_gemm(lds, Z + OZ_GB, DM, (const bf16*)(ws + WS_WO), DM, DM, E, gridDim.x == 256 ? MP : MT); }
        GSYNC(64);
        { PHASE_PTRS(); EpiUp E{H, st2, cs13b, cb13b}; if (GEMSEL & 64) run_gemm(lds, VB, DM, (const bf16*)(ws + WS_W13B), NUP, DM, E, gridDim.x == 256 ? MP : MT); }
        GSYNC(2);
        { PHASE_PTRS(); EpiRes E{V, V, VB, st2, lng + (l * 3 + 1) * DM, lnb + (l * 3 + 1) * DM, st3, 0.5f}; if (GEMSEL & 128) run_gemm(lds, H, DFF, (const bf16*)(ws + WS_W2B), DM, DFF, E, gridDim.x == 256 ? MP : MT); }
        GSYNC(4);
    }
    { const int l = DEPTH - 1; PHASE_PTRS(); const int tid = threadIdx.x, G = gridDim.x, bx = blockIdx.x;
      const int* st = stats + (size_t)12 * MT * 2; const float* g = lng + 11 * DM; const float* b = lnb + 11 * DM; const int lane = tid & 63, wave = tid >> 6;
      f32x4 gv[4], bv[4];
#pragma unroll
      for (int j = 0; j < 4; ++j) { gv[j] = *(const f32x4*)(g + 4 * lane + 256 * j); bv[j] = *(const f32x4*)(b + 4 * lane + 256 * j); }
      for (int m = bx * 8 + wave; m < MT; m += G * 8) { float mu, rstd; row_stat(st, m, mu, rstd); float* vr = V + (size_t)m * DM + 4 * lane;
#pragma unroll
          for (int j = 0; j < 4; ++j) { const f32x4 v = *(const f32x4*)(vr + 256 * j); *(f32x4*)(vr + 256 * j) = (v - mu) * rstd * gv[j] + bv[j]; } } }
    if (PROBE_MASK & 256) GSYNC(256);
}

extern "C" void kernel_launch(void* const* d_in, const int* in_sizes, int n_in, void* d_out, int out_size, void* d_ws, size_t ws_size, hipStream_t stream) {
    static int grid = 0;
    if (grid == 0) {
        if (n_in != 19 || (size_t)out_size != OUT_END || ws_size < WS_END) { fprintf(stderr, "kernel_launch: unexpected shapes: n_in %d out %d ws %zu (need %zu)\n", n_in, out_size, ws_size, (size_t)WS_END); grid = -1; return; }
        int dev = 0, cus = 0, per_cu = 0;
        if (hipGetDevice(&dev) != hipSuccess || hipDeviceGetAttribute(&cus, hipDeviceAttributeMultiprocessorCount, dev) != hipSuccess) { grid = -1; return; }
        if (hipFuncSetAttribute((const void*)fwd_megakernel, hipFuncAttributeMaxDynamicSharedMemorySize, LDS_BYTES) != hipSuccess) { fprintf(stderr, "kernel_launch: hipFuncSetAttribute failed\n"); grid = -1; return; }
        if (hipOccupancyMaxActiveBlocksPerMultiprocessor(&per_cu, (const void*)fwd_megakernel, 512, LDS_BYTES) != hipSuccess || per_cu < 1) { fprintf(stderr, "kernel_launch: occupancy query gives %d\n", per_cu); per_cu = 1; }
        (void)hipGetLastError();
        grid = cus;
    }
    if (grid < 0) return;
    (void)hipMemsetAsync(d_ws, 0, ZERO_BYTES, stream);
    Params p{};
    for (int i = 0; i < 19; ++i) p.in[i] = (const float*)d_in[i];
    p.out = (float*)d_out; p.ws = (unsigned char*)d_ws;
    void* args[] = {&p};
    hipError_t e = hipLaunchCooperativeKernel((const void*)fwd_megakernel, dim3(grid), dim3(512), args, LDS_BYTES, stream);
    if (e != hipSuccess) fprintf(stderr, "cooperative launch failed: %s (grid %d)\n", hipGetErrorString(e), grid);
}
```

```cpp
#include <hip/hip_runtime.h>
#include <hip/hip_cooperative_groups.h>
#include <cstdio>
#include <cstdint>
namespace cg = cooperative_groups;

namespace pg8 {
#define PG8_LAS __attribute__((address_space(3)))
typedef unsigned short bf16_t;
typedef short bf16x8 __attribute__((ext_vector_type(8)));
typedef float f32x4 __attribute__((ext_vector_type(4)));
typedef unsigned u32x4 __attribute__((ext_vector_type(4)));
constexpr int BM = 256, BK = 64, HALF = 128, HTB = HALF * BK * 2  , STAGE_BYTES = 8 * HTB, NXCD = 8, WGM = 8;

__host__ __device__ __forceinline__ int lds_byte(int r, int c) { const int st = (r >> 4) * 2 + (c >> 5), rr = r & 15, cc = c & 31, ob = rr * 64 + cc * 2; return st * 1024 + (ob ^ (((ob >> 9) & 1) << 5)); }
__host__ __device__ __forceinline__ void stage_rc(int b, int& R, int& C) { const int st = b / 1024, sb = b % 1024, swz = sb ^ (((sb >> 9) & 1) << 5); R = (st >> 1) * 16 + swz / 64; C = (st & 1) * 32 + (swz % 64) / 2; }
__host__ __device__ __forceinline__ int perm32(int rho) { const int n = rho >> 4, i = rho & 15; return 8 * (i >> 2) + 4 * n + (i & 3); }

struct Unit { int pm, pn; };
struct Gemm { const bf16_t* A; const bf16_t* Bt; int lda, M, N, K; };

struct StaticOrder {
    int nM, nN, nwg, G, c;
    __host__ __device__ void init(int M, int N, int G_, int c_) { nM = M / BM; nN = N / BM; nwg = nM * nN; G = G_; c = c_; }
    __host__ __device__ bool next(int i, Unit& u) const {
        const long L = (long)i * G + c; if (L >= nwg) return false;
        int wgid = (int)L; { const int q = nwg / NXCD, r = nwg % NXCD, xcd = wgid % NXCD, off = wgid / NXCD; wgid = (xcd < r ? xcd * (q + 1) : r * (q + 1) + (xcd - r) * q) + off; }
        const int nig = WGM * nN, gid = wgid / nig, fm = gid * WGM, gsz = (nM - fm) < WGM ? (nM - fm) : WGM;
        u.pm = fm + ((wgid % nig) % gsz); u.pn = (wgid % nig) / gsz; return true;
    }
    __device__ __forceinline__ void a_ready(const Unit&) const {}
    __device__ __forceinline__ void done(const Unit&) const {}
};
__device__ __forceinline__ unsigned cvt_pk_bf16(float lo, float hi) { unsigned r; asm volatile("v_cvt_pk_bf16_f32 %0, %1, %2" : "=v"(r) : "v"(lo), "v"(hi)); return r; }
typedef float f32x2 __attribute__((ext_vector_type(2)));
__device__ __forceinline__ f32x2 gelu_pk(f32x2 v) {
    const f32x2 av = __builtin_elementwise_abs(v), d = av * 0.2316418882f + 1.0f;
    f32x2 t; t.x = __builtin_amdgcn_rcpf(d.x); t.y = __builtin_amdgcn_rcpf(d.y);
    f32x2 q = t * 0.5307027145f + (-0.7265760135f); q = q * t + 0.7107068705f; q = q * t + (-0.142248368f); q = q * t + 0.127414796f; q = q * t;
    const f32x2 s = (v * v) * (-0.72134752044f);
    f32x2 e; e.x = __builtin_amdgcn_exp2f(s.x); e.y = __builtin_amdgcn_exp2f(s.y);
    const f32x2 m = v * (q * e), r = v - m;
    f32x2 o; o.x = v.x < 0.f ? m.x : r.x; o.y = v.y < 0.f ? m.y : r.y; return o;
}

template <class Epi, class Sched, bool ALIGN_EPI = false, bool SP2 = false>
__device__ __forceinline__ void gemm_phase(PG8_LAS unsigned char* lds, const Gemm g, const Sched& S, const Epi& E) {
    int tid = threadIdx.x; asm volatile("" : "+v"(tid));
    const int wid = __builtin_amdgcn_readfirstlane(tid >> 6), lane = tid & 63, wr = wid >> 2, wc = wid & 3, fr = lane & 15, fq = lane >> 4;
    const int K = g.K, nt = K / BK;
    unsigned voffA[2], voffB[2];
#pragma unroll
    for (int i = 0; i < 2; ++i) { int R, C; stage_rc(tid * 16 + i * 8192, R, C); const int Rb = Epi::PERM ? ((R & ~31) + perm32(R & 31)) : R;
        voffA[i] = (unsigned)(R * g.lda + C) * 2u; voffB[i] = (unsigned)(Rb * K + C) * 2u; }
    const size_t kstep = (size_t)(BK * 2);
    const size_t hstepA = (size_t)HALF * g.lda * 2, hstepB = (size_t)HALF * K * 2;
    const size_t tstepA = 2 * hstepA, tstepB = 2 * hstepB;
    const unsigned ldsw = (unsigned)wid * 1024u;
    const int aoff = lds_byte(wr * 64 + fr, fq * 8), boff = lds_byte(wc * 32 + fr, fq * 8);
#define PG8_SA(b, h) (((b) * 2 + (h)) * HTB)
#define PG8_SB(b, h) ((4 + (b) * 2 + (h)) * HTB)
#define PG8_STAGE(bufoff, gbase, voff) do { _Pragma("unroll") for (int _i = 0; _i < 2; ++_i) \
        __builtin_amdgcn_global_load_lds((const unsigned*)((const char*)(gbase) + (voff)[_i]), (PG8_LAS unsigned*)(lds + (bufoff) + ldsw + _i * 8192), 16, 0, 0); } while (0)
#define PG8_LDA(dst, b, h) do { _Pragma("unroll") for (int m = 0; m < 4; ++m) _Pragma("unroll") for (int k = 0; k < 2; ++k) dst[m][k] = *(const PG8_LAS bf16x8*)(lds + PG8_SA(b, h) + aoff + m * 2048 + k * 1024); } while (0)
#define PG8_LDB(dst, b, h) do { _Pragma("unroll") for (int n = 0; n < 2; ++n) _Pragma("unroll") for (int k = 0; k < 2; ++k) dst[n][k] = *(const PG8_LAS bf16x8*)(lds + PG8_SB(b, h) + boff + n * 2048 + k * 1024); } while (0)
#define PG8_MMA(ai, bj, At, Bt) do { __builtin_amdgcn_s_setprio(1); _Pragma("unroll") for (int m = 0; m < 4; ++m) _Pragma("unroll") for (int n = 0; n < 2; ++n) _Pragma("unroll") for (int k = 0; k < 2; ++k) \
        acc[ai][bj][m][n] = __builtin_amdgcn_mfma_f32_16x16x32_bf16(Bt[n][k], At[m][k], acc[ai][bj][m][n], 0, 0, 0); __builtin_amdgcn_s_setprio(0); } while (0)
#define PG8_WAIT_V(n) asm volatile("s_waitcnt vmcnt(" #n ")" ::: "memory")
#define PG8_WAIT_L(n) asm volatile("s_waitcnt lgkmcnt(" #n ")" ::: "memory")
#define PG8_BAR __builtin_amdgcn_s_barrier()
#define PG8_SCHED __builtin_amdgcn_sched_barrier(0)
    Unit cur, nxt; int ui = 0;
    if (!S.next(0, cur)) return;
    f32x4 acc[2][2][4][2];
#pragma unroll
    for (int a = 0; a < 2; ++a)
#pragma unroll
        for (int b = 0; b < 2; ++b)
#pragma unroll
            for (int m = 0; m < 4; ++m)
#pragma unroll
                for (int n = 0; n < 2; ++n) acc[a][b][m][n] = (f32x4){0.f, 0.f, 0.f, 0.f};
    bf16x8 At[4][2], B0[2][2], B1[2][2];
    const char* cA = (const char*)g.A + (size_t)cur.pm * tstepA; const char* cB = (const char*)g.Bt + (size_t)cur.pn * tstepB;
    S.a_ready(cur);
    if constexpr (SP2) {
        PG8_STAGE(PG8_SB(0, 0), cB, voffB); PG8_STAGE(PG8_SB(0, 1), cB + hstepB, voffB); PG8_STAGE(PG8_SA(0, 0), cA, voffA); PG8_STAGE(PG8_SA(0, 1), cA + hstepA, voffA);
        if (wr == 1) PG8_BAR;
        PG8_WAIT_V(2); PG8_BAR;
        PG8_STAGE(PG8_SB(1, 0), cB + kstep, voffB); PG8_STAGE(PG8_SA(1, 0), cA + kstep, voffA); PG8_STAGE(PG8_SB(1, 1), cB + hstepB + kstep, voffB);
        PG8_WAIT_V(6); PG8_BAR;
    } else {
        PG8_STAGE(PG8_SB(0, 0), cB, voffB); PG8_STAGE(PG8_SA(0, 0), cA, voffA); PG8_STAGE(PG8_SB(0, 1), cB + hstepB, voffB); PG8_STAGE(PG8_SA(0, 1), cA + hstepA, voffA);
        if (wr == 1) PG8_BAR;
        PG8_WAIT_V(4); PG8_BAR;
        PG8_STAGE(PG8_SB(1, 0), cB + kstep, voffB); PG8_STAGE(PG8_SA(1, 0), cA + kstep, voffA); PG8_STAGE(PG8_SB(1, 1), cB + hstepB + kstep, voffB);
        PG8_WAIT_V(6); PG8_BAR;
    }
    for (;;) {
        const bool has_next = S.next(ui + 1, nxt);
        const char* nA = has_next ? (const char*)g.A + (size_t)nxt.pm * tstepA : cA; const char* nB = has_next ? (const char*)g.Bt + (size_t)nxt.pn * tstepB : cB;
        for (int t = 0; t < nt; t += 2) {
            const bool last = (t == nt - 2);
            const char* a1 = cA + (size_t)(t + 1) * kstep;
            const char* a2 = last ? nA : cA + (size_t)(t + 2) * kstep; const char* b2 = last ? nB : cB + (size_t)(t + 2) * kstep;
            const char* a3 = a2 + kstep; const char* b3 = b2 + kstep;
            if (last && has_next) S.a_ready(nxt);
            if constexpr (SP2) {
            PG8_LDB(B0, 0, 0); PG8_LDB(B1, 0, 1); PG8_SCHED; PG8_LDA(At, 0, 0); PG8_STAGE(PG8_SA(1, 1), a1 + hstepA, voffA);
            PG8_WAIT_V(8); PG8_WAIT_L(0); PG8_BAR; PG8_MMA(0, 0, At, B0); PG8_MMA(0, 1, At, B1); PG8_BAR; PG8_SCHED;
            PG8_LDA(At, 0, 1); PG8_STAGE(PG8_SB(0, 0), b2, voffB); PG8_STAGE(PG8_SB(0, 1), b2 + hstepB, voffB); PG8_STAGE(PG8_SA(0, 0), a2, voffA);
            PG8_WAIT_V(8); PG8_WAIT_L(0); PG8_BAR; PG8_MMA(1, 0, At, B0); PG8_MMA(1, 1, At, B1); PG8_BAR; PG8_SCHED;
            PG8_LDB(B0, 1, 0); PG8_LDB(B1, 1, 1); PG8_SCHED; PG8_LDA(At, 1, 0); PG8_STAGE(PG8_SA(0, 1), a2 + hstepA, voffA);
            PG8_WAIT_V(8); PG8_WAIT_L(0); PG8_BAR; PG8_MMA(0, 0, At, B0); PG8_MMA(0, 1, At, B1); PG8_BAR; PG8_SCHED;
            PG8_LDA(At, 1, 1); PG8_STAGE(PG8_SB(1, 0), b3, voffB); PG8_STAGE(PG8_SB(1, 1), b3 + hstepB, voffB); PG8_STAGE(PG8_SA(1, 0), a3, voffA);
            PG8_WAIT_V(8); PG8_WAIT_L(0); PG8_BAR; PG8_MMA(1, 0, At, B0); PG8_MMA(1, 1, At, B1); PG8_BAR; PG8_SCHED;
            } else {
            PG8_LDB(B0, 0, 0); PG8_SCHED; PG8_LDA(At, 0, 0); PG8_STAGE(PG8_SA(1, 1), a1 + hstepA, voffA);
            PG8_WAIT_L(8); PG8_BAR; PG8_WAIT_L(0); PG8_MMA(0, 0, At, B0); PG8_BAR; PG8_SCHED;
            PG8_LDB(B1, 0, 1); PG8_STAGE(PG8_SB(0, 0), b2, voffB);
            PG8_BAR; PG8_WAIT_L(0); PG8_MMA(0, 1, At, B1); PG8_BAR;
            PG8_LDA(At, 0, 1); PG8_STAGE(PG8_SA(0, 0), a2, voffA);
            PG8_BAR; PG8_WAIT_L(0); PG8_MMA(1, 0, At, B0); PG8_BAR; PG8_SCHED;
            PG8_STAGE(PG8_SB(0, 1), b2 + hstepB, voffB);
            PG8_WAIT_V(6); PG8_BAR; PG8_MMA(1, 1, At, B1); PG8_BAR;
            PG8_LDB(B0, 1, 0); PG8_SCHED; PG8_LDA(At, 1, 0); PG8_STAGE(PG8_SA(0, 1), a2 + hstepA, voffA);
            PG8_WAIT_L(8); PG8_BAR; PG8_WAIT_L(0); PG8_MMA(0, 0, At, B0); PG8_BAR; PG8_SCHED;
            PG8_LDB(B1, 1, 1); PG8_STAGE(PG8_SB(1, 0), b3, voffB);
            PG8_BAR; PG8_WAIT_L(0); PG8_MMA(0, 1, At, B1); PG8_BAR;
            PG8_LDA(At, 1, 1); PG8_STAGE(PG8_SA(1, 0), a3, voffA);
            PG8_BAR; PG8_WAIT_L(0); PG8_MMA(1, 0, At, B0); PG8_BAR; PG8_SCHED;
            PG8_STAGE(PG8_SB(1, 1), b3 + hstepB, voffB);
            PG8_WAIT_V(6); PG8_BAR; PG8_MMA(1, 1, At, B1); PG8_BAR;
            }
        }
        if constexpr (ALIGN_EPI) { if (wr == 0) PG8_BAR; }
        if constexpr (!Epi::AFTER_DRAIN) { E(acc, cur, wr, wc, fr, fq); S.done(cur); }
        if (!has_next) break;
#pragma unroll
        for (int a = 0; a < 2; ++a)
#pragma unroll
            for (int b = 0; b < 2; ++b)
#pragma unroll
                for (int m = 0; m < 4; ++m)
#pragma unroll
                    for (int n = 0; n < 2; ++n) acc[a][b][m][n] = (f32x4){0.f, 0.f, 0.f, 0.f};
        cur = nxt; cA = nA; cB = nB; ++ui;
        if constexpr (ALIGN_EPI) { if (wr == 1) PG8_BAR; }
    }
    PG8_WAIT_V(0);
    if constexpr (!ALIGN_EPI) { if (wr == 0) PG8_BAR; }
    PG8_BAR;
    if constexpr (Epi::AFTER_DRAIN) { E.fused(acc, cur, wr, wc, fr, fq, lds, wid, lane); S.done(cur); }
#undef PG8_SA
#undef PG8_SB
#undef PG8_STAGE
#undef PG8_LDA
#undef PG8_LDB
#undef PG8_MMA
#undef PG8_WAIT_V
#undef PG8_WAIT_L
#undef PG8_BAR
#undef PG8_SCHED
}
}

#define LAS __attribute__((address_space(3)))
typedef unsigned short bf16;
typedef pg8::f32x4 f32x4;
typedef pg8::f32x2 f32x2;
typedef pg8::u32x4 u32x4;
typedef pg8::bf16x8 bf16x8;
typedef unsigned u32x2 __attribute__((ext_vector_type(2)));
constexpr int DM = 1024, NBATCH = 16, SEQ = 2048, DEPTH = 4, DBATCH = 8, DSEQ = 64;
constexpr int MP = NBATCH * SEQ, MS = DBATCH * DSEQ, MT = MP + MS;
constexpr int DFF = 2816, NUP = 2 * DFF, INC = 6160, NIN = 6400, ZW = 6144;
constexpr int ZU = 0, ZV = 512, ZQ = 1024, ZK = 1536, ZVG = 2048, ZGG = 3072, ZGA = 4096, ZGB = 5120;
constexpr size_t OZ_U = 0, OZ_V = (size_t)MT * 512, OZ_Q = (size_t)MT * 1024, OZ_K = (size_t)MT * 1536, OZ_VG = (size_t)MT * 2048, OZ_GG = (size_t)MT * 3072, OZ_GA = (size_t)MT * 4096, OZ_GB = (size_t)MT * 5120;
constexpr int NCHUNK = MT / 64;
constexpr float ALPHA = 1.6817928305074290f, LN_EPS = 1e-5f;
constexpr size_t STAT_BYTES = (size_t)MT * 2 * 4;
constexpr size_t WS_STATS = 0;
constexpr size_t WS_GST = WS_STATS + 13 * STAT_BYTES;
constexpr int CSCB_L = 2 * (NUP + NIN + NUP);
constexpr size_t ZERO_BYTES = 5u << 20;
constexpr size_t WS_CSCB = WS_GST + 4 * STAT_BYTES;
constexpr size_t WS_BAR = WS_CSCB + (size_t)DEPTH * CSCB_L * 4;
constexpr size_t WS_SUB = WS_BAR + 3456 * 4;
static_assert(WS_BAR % 256 == 0 && WS_SUB + 7 * DEPTH * 256 <= ZERO_BYTES, "zero region");
constexpr size_t WS_ONES = ZERO_BYTES;
constexpr size_t WS_W13A = WS_ONES + 65536;
constexpr size_t WS_W2A = WS_W13A + (size_t)NUP * DM * 2;
constexpr size_t WS_WIN = WS_W2A + (size_t)DM * DFF * 2;
constexpr size_t WS_WPA = WS_WIN + (size_t)NIN * DM * 2;
constexpr size_t WS_WPB = WS_WPA + (size_t)DM * 512 * 2;
constexpr size_t WS_WO = WS_WPB + (size_t)DM * DM * 2;
constexpr size_t WS_W13B = WS_WO + (size_t)DM * DM * 2;
constexpr size_t WS_W2B = WS_W13B + (size_t)NUP * DM * 2;
constexpr size_t WS_WSB = WS_W2B + (size_t)DM * DFF * 2;
constexpr size_t WS_GLR = WS_WSB + 4 * 128 * 128 * 2;
constexpr size_t WS_DEC = WS_GLR + (size_t)MT * 16 * 4;
constexpr size_t WS_VB = WS_DEC + (size_t)NCHUNK * 512 * 4;
constexpr size_t WS_Z = WS_VB + (size_t)MT * DM * 2;
constexpr size_t WS_HS = WS_Z + (size_t)MT * ZW * 2;
constexpr size_t WS_END = WS_HS + (size_t)MS * DFF * 2;
constexpr size_t OUT_SP = (size_t)MT * DM, OUT_SS = OUT_SP + (size_t)DEPTH * NBATCH * 4 * 128 * 256, OUT_VN = OUT_SS + (size_t)DEPTH * DBATCH * 4 * 128 * 256;
constexpr size_t OUT_END = OUT_VN + (size_t)DEPTH * DBATCH * DSEQ * 512;
constexpr int LDS_BYTES = 147456;

struct Params { const float* in[19]; float* out; unsigned char* ws; };
enum { I_XP = 0, I_XS, I_STATE, I_LNG, I_LNB, I_W1, I_W3, I_W2, I_WIN, I_GMG, I_GMB, I_GMWS, I_GMBS, I_WA2, I_BA, I_GNG, I_WPA, I_WPB, I_WO };

__device__ __forceinline__ unsigned f2bf(float f) { unsigned u = __float_as_uint(f); return (u + 0x7fffu + ((u >> 16) & 1u)) >> 16; }
__device__ __forceinline__ float bf2f(unsigned h) { return __uint_as_float(h << 16); }
__device__ __forceinline__ float bflo(unsigned w) { return __uint_as_float(w << 16); }
__device__ __forceinline__ float bfhi(unsigned w) { return __uint_as_float(w & 0xffff0000u); }
__device__ __forceinline__ unsigned pk2(float lo, float hi) { return pg8::cvt_pk_bf16(lo, hi); }
__device__ __forceinline__ float sigmoidf_(float x) { return __builtin_amdgcn_rcpf(1.0f + __expf(-x)); }
constexpr float FXS = 65536.0f, FXS_INV = 1.0f / 65536.0f;
constexpr float FXQ = 4096.0f, FXQ_INV = 1.0f / 4096.0f;
__device__ __forceinline__ void fx_add(int* p, float v, float scale) { atomicAdd(p, (int)(v * scale)); }
__device__ __forceinline__ void row_stat(const int* st, int r, float& mu, float& rstd) {
    const int2 s = *(const int2*)(st + 2 * (size_t)r); mu = (float)s.x * (FXS_INV / DM); const float var = fmaxf((float)s.y * (FXQ_INV / DM) - mu * mu, 0.f); rstd = rsqrtf(var + LN_EPS);
}
typedef int i32x4 __attribute__((ext_vector_type(4)));
__device__ __forceinline__ f32x4 ld_cs4(const int* p) { const i32x4 v = *(const i32x4*)p; return (f32x4){(float)v.x, (float)v.y, (float)v.z, (float)v.w} * (1.0f / 16777216.0f); }
#define LDS_WAIT() asm volatile("s_waitcnt lgkmcnt(0)" ::: "memory")

struct EpiUp {
    static constexpr bool PERM = true, AFTER_DRAIN = false;
    bf16* H; const int* st; const int* cs; const int* cb;
    __device__ __forceinline__ void operator()(const f32x4 (&acc)[2][2][4][2], const pg8::Unit& u, int wr, int wc, int fr, int fq) const {
        const int row0 = u.pm * 256 + wr * 64 + fr, cidx = u.pn * 256 + wc * 32 + 8 * fq, hcol = u.pn * 128 + wc * 32 + 8 * fq;
        f32x4 s1[2], s3[2], b1[2], b3[2];
#pragma unroll
        for (int n = 0; n < 2; ++n) { s1[n] = ld_cs4(cs + cidx + 4 * n); s3[n] = ld_cs4(cs + cidx + 128 + 4 * n); b1[n] = ld_cs4(cb + cidx + 4 * n); b3[n] = ld_cs4(cb + cidx + 128 + 4 * n); }
#pragma unroll
        for (int ai = 0; ai < 2; ++ai)
#pragma unroll
            for (int m = 0; m < 4; ++m) {
                const int r = row0 + ai * 128 + m * 16; float mu, rstd; row_stat(st, r, mu, rstd);
                f32x4 h[2];
#pragma unroll
                for (int n = 0; n < 2; ++n) {
                    const f32x4 a1 = (acc[ai][0][m][n] - mu * s1[n]) * rstd + b1[n], a3 = (acc[ai][1][m][n] - mu * s3[n]) * rstd + b3[n];
#pragma unroll
                    for (int j = 0; j < 4; ++j) h[n][j] = a1[j] * sigmoidf_(a1[j]) * a3[j];
                }
                u32x4 w; w.x = pk2(h[0][0], h[0][1]); w.y = pk2(h[0][2], h[0][3]); w.z = pk2(h[1][0], h[1][1]); w.w = pk2(h[1][2], h[1][3]);
                *(u32x4*)(H + (size_t)r * DFF + hcol) = w;
                if (m & 1) asm volatile("" ::: "memory");
            }
    }
};
struct EpiZ {
    static constexpr bool PERM = true, AFTER_DRAIN = false;
    bf16* Z; const int* st; const int* cs; const int* cb; int* gst; float* glr;
    __device__ __forceinline__ void operator()(const f32x4 (&acc)[2][2][4][2], const pg8::Unit& u, int wr, int wc, int fr, int fq) const {
        const int row0 = u.pm * 256 + wr * 64 + fr, col0 = u.pn * 256 + wc * 32 + 8 * fq, pn = u.pn;
        const int kind = pn < 4 ? 0 : pn < 12 ? 1 : pn < 16 ? 2 : pn < 24 ? 3 : 4;
        const int zld = pn < 8 ? 512 : 1024;
        f32x4 sv[2][2], bv[2][2];
#pragma unroll
        for (int bj = 0; bj < 2; ++bj)
#pragma unroll
            for (int n = 0; n < 2; ++n) { sv[bj][n] = ld_cs4(cs + col0 + bj * 128 + 4 * n); bv[bj][n] = ld_cs4(cb + col0 + bj * 128 + 4 * n); }
        bf16* zg = Z + (pn < 8 ? (size_t)(pn >> 1) * MT * 512 + (pn & 1) * 256 : (size_t)MT * 2048 + (size_t)((pn - 8) >> 2) * MT * 1024 + ((pn - 8) & 3) * 256) + wc * 32 + 8 * fq;
#pragma unroll
        for (int ai = 0; ai < 2; ++ai)
#pragma unroll
            for (int m = 0; m < 4; ++m) {
                const int r = row0 + ai * 128 + m * 16; float mu, rstd; row_stat(st, r, mu, rstd);
                float s = 0.f, ss = 0.f;
#pragma unroll
                for (int bj = 0; bj < 2; ++bj) {
                    f32x4 v[2];
#pragma unroll
                    for (int n = 0; n < 2; ++n) {
                        v[n] = (acc[ai][bj][m][n] - mu * sv[bj][n]) * rstd + bv[bj][n];
                        if (kind == 0) { const f32x2 a = pg8::gelu_pk((f32x2){v[n][0], v[n][1]}), b = pg8::gelu_pk((f32x2){v[n][2], v[n][3]}); v[n] = (f32x4){a.x, a.y, b.x, b.y}; }
                        else if (kind == 2) {
#pragma unroll
                            for (int j = 0; j < 4; ++j) v[n][j] = v[n][j] * sigmoidf_(v[n][j]); }
                        else if (kind == 3) {
#pragma unroll
                            for (int j = 0; j < 4; ++j) v[n][j] = sigmoidf_(v[n][j]); }
                        s += (v[n][0] + v[n][1]) + (v[n][2] + v[n][3]); ss += (v[n][0] * v[n][0] + v[n][1] * v[n][1]) + (v[n][2] * v[n][2] + v[n][3] * v[n][3]);
                    }
                    if (kind != 4) { u32x4 w; w.x = pk2(v[0][0], v[0][1]); w.y = pk2(v[0][2], v[0][3]); w.z = pk2(v[1][0], v[1][1]); w.w = pk2(v[1][2], v[1][3]);
                        *(u32x4*)(zg + (size_t)r * zld + bj * 128) = w; }
                    else if (bj == 0 && wc == 0 && fq < 2) { *(f32x4*)(glr + (size_t)r * 16 + 8 * fq) = v[0]; *(f32x4*)(glr + (size_t)r * 16 + 8 * fq + 4) = v[1]; }
                }
                if (pn == 2 || pn == 3) { s += __shfl_xor(s, 16); s += __shfl_xor(s, 32); ss += __shfl_xor(ss, 16); ss += __shfl_xor(ss, 32);
                    if (fq == 0) { fx_add(gst + 2 * (size_t)r, s, FXS); fx_add(gst + 2 * (size_t)r + 1, ss, FXQ); } }
                asm volatile("" ::: "memory");
            }
    }
};
struct EpiRes {
    static constexpr bool PERM = true, AFTER_DRAIN = false;
    const float* Vin; float* V; bf16* VB; const int* st_in; const float* g_in; const float* b_in; int* st_out; float ascale;
    __device__ __forceinline__ void operator()(const f32x4 (&acc)[2][2][4][2], const pg8::Unit& u, int wr, int wc, int fr, int fq) const {
        const int row0 = u.pm * 256 + wr * 64 + fr, col0 = u.pn * 256 + wc * 32 + 8 * fq;
        f32x4 gv[2][2], bv[2][2];
#pragma unroll
        for (int bj = 0; bj < 2; ++bj)
#pragma unroll
            for (int n = 0; n < 2; ++n) { gv[bj][n] = *(const f32x4*)(g_in + col0 + bj * 128 + 4 * n) * ALPHA; bv[bj][n] = *(const f32x4*)(b_in + col0 + bj * 128 + 4 * n) * ALPHA; }
#pragma unroll
        for (int ai = 0; ai < 2; ++ai)
#pragma unroll
            for (int m = 0; m < 4; ++m) {
                const int r = row0 + ai * 128 + m * 16; float mu, rstd; row_stat(st_in, r, mu, rstd);
                float s = 0.f, ss = 0.f; float* vp = V + (size_t)r * DM + col0; bf16* vbp = VB + (size_t)r * DM + col0;
#pragma unroll
                for (int bj = 0; bj < 2; ++bj) {
                    f32x4 o[2];
#pragma unroll
                    for (int n = 0; n < 2; ++n) {
                        const f32x4 vin = *(const f32x4*)(Vin + (size_t)r * DM + col0 + bj * 128 + 4 * n);
                        o[n] = ((vin - mu) * rstd) * gv[bj][n] + (bv[bj][n] + acc[ai][bj][m][n] * ascale);
                        *(f32x4*)(vp + bj * 128 + 4 * n) = o[n];
                        s += (o[n][0] + o[n][1]) + (o[n][2] + o[n][3]); ss += (o[n][0] * o[n][0] + o[n][1] * o[n][1]) + (o[n][2] * o[n][2] + o[n][3] * o[n][3]);
                    }
                    u32x4 w; w.x = pk2(o[0][0], o[0][1]); w.y = pk2(o[0][2], o[0][3]); w.z = pk2(o[1][0], o[1][1]); w.w = pk2(o[1][2], o[1][3]);
                    *(u32x4*)(vbp + bj * 128) = w;
                }
                s += __shfl_xor(s, 16); s += __shfl_xor(s, 32); ss += __shfl_xor(ss, 16); ss += __shfl_xor(ss, 32);
                if (fq == 0) { fx_add(st_out + 2 * (size_t)r, s, FXS); fx_add(st_out + 2 * (size_t)r + 1, ss, FXQ); }
                asm volatile("" ::: "memory");
            }
    }
};
template <bool SECOND> struct EpiGate {
    static constexpr bool PERM = true, AFTER_DRAIN = false;
    bf16* Z;
    __device__ __forceinline__ void operator()(const f32x4 (&acc)[2][2][4][2], const pg8::Unit& u, int wr, int wc, int fr, int fq) const {
        const int row0 = u.pm * 256 + wr * 64 + fr, col0 = u.pn * 256 + wc * 32 + 8 * fq;
#pragma unroll
        for (int ai = 0; ai < 2; ++ai)
#pragma unroll
            for (int m = 0; m < 4; ++m) {
                bf16* zr = Z + (size_t)(row0 + ai * 128 + m * 16) * 1024 + col0;
#pragma unroll
                for (int bj = 0; bj < 2; ++bj) {
                    bf16* pg = zr + (SECOND ? OZ_GB : OZ_GA) + bj * 128;
                    const u32x4 g = *(const u32x4*)pg; u32x4 t = (u32x4){0u, 0u, 0u, 0u};
                    if (SECOND) t = *(const u32x4*)(zr + OZ_GA + bj * 128);
                    const f32x4 a0 = acc[ai][bj][m][0], a1 = acc[ai][bj][m][1];
                    u32x4 w;
                    w.x = pk2(bflo(t.x) + bflo(g.x) * a0[0], bfhi(t.x) + bfhi(g.x) * a0[1]);
                    w.y = pk2(bflo(t.y) + bflo(g.y) * a0[2], bfhi(t.y) + bfhi(g.y) * a0[3]);
                    w.z = pk2(bflo(t.z) + bflo(g.z) * a1[0], bfhi(t.z) + bfhi(g.z) * a1[1]);
                    w.w = pk2(bflo(t.w) + bflo(g.w) * a1[2], bfhi(t.w) + bfhi(g.w) * a1[3]);
                    *(u32x4*)pg = w;
                }
                asm volatile("" ::: "memory");
            }
    }
};

constexpr float FXC = 16777216.0f, FXC_INV = 1.0f / 16777216.0f;
__device__ __forceinline__ void conv_item(const float* W, int ldw, int src_c0, int nvalid, int k0, bf16* WT, int K, int dst_n0,
                                          const float* g, const float* b, float scale, int* cs, int* cb, LAS float* scr, int lane) {
    const float* wp = W + (size_t)k0 * ldw + src_c0 + lane;
    const bool ok = lane < nvalid;
    float sc = 0.f, sb = 0.f;
#pragma unroll
    for (int hb = 0; hb < 2; ++hb) {
        float w[32];
#pragma unroll
        for (int i = 0; i < 32; ++i) w[i] = ok ? wp[(size_t)(32 * hb + i) * ldw] : 0.f;
#pragma unroll
        for (int i = 0; i < 32; ++i) { const int kk = 32 * hb + i; const float ws_ = w[i] * scale; const float gk = g ? g[k0 + kk] : 1.f, bk = b ? b[k0 + kk] : 0.f;
            const float wf = bf2f(f2bf(ws_ * gk)); scr[kk * 65 + lane] = wf; sc += wf; sb += ws_ * bk; }
        asm volatile("" ::: "memory");
    }
    if (cs) { atomicAdd(cs + dst_n0 + lane, (int)(sc * FXC)); atomicAdd(cb + dst_n0 + lane, (int)(sb * FXC)); }
    LDS_WAIT();
    const int c = lane & 7;
#pragma unroll
    for (int j = 0; j < 8; ++j) { const int nn = (lane >> 3) + 8 * j; const LAS float* s = scr + (8 * c) * 65 + nn;
        u32x4 o;
        o.x = (__float_as_uint(s[0 * 65]) >> 16) | (__float_as_uint(s[1 * 65]) & 0xffff0000u); o.y = (__float_as_uint(s[2 * 65]) >> 16) | (__float_as_uint(s[3 * 65]) & 0xffff0000u);
        o.z = (__float_as_uint(s[4 * 65]) >> 16) | (__float_as_uint(s[5 * 65]) & 0xffff0000u); o.w = (__float_as_uint(s[6 * 65]) >> 16) | (__float_as_uint(s[7 * 65]) & 0xffff0000u);
        *(u32x4*)(WT + (size_t)(dst_n0 + nn) * K + k0 + 8 * c) = o; }
    LDS_WAIT();
}
__device__ __forceinline__ void convert_phase(const Params& P, int l, LAS unsigned char* lds) {
    int tid = threadIdx.x; asm volatile("" : "+v"(tid));
    const int lane = tid & 63, wave = __builtin_amdgcn_readfirstlane(tid >> 6), G = gridDim.x;
    LAS float* scr = (LAS float*)(lds + wave * 16640);
    unsigned char* ws = P.ws;
    const float* lng = P.in[I_LNG]; const float* lnb = P.in[I_LNB];
    int* cscb = (int*)(ws + WS_CSCB) + (size_t)l * CSCB_L;
    int *cs13a = cscb, *cb13a = cscb + NUP, *csin = cscb + 2 * NUP, *cbin = csin + NIN, *cs13b = cbin + NIN, *cb13b = cs13b + NUP;
    const int gw = blockIdx.x * 8 + wave, NGW = G * 8;
    constexpr int I_UP = 16 * 44, I_DN = 44 * 16, I_IN = 16 * 100, I_PA = 8 * 16, I_PB = 16 * 16;
    constexpr int NITEMS = 4 * I_UP + 2 * I_DN + I_IN + I_PA + 2 * I_PB;
    for (int it = gw; it < NITEMS; it += NGW) {
        int r = it;
        if (r < 4 * I_UP) {
            const int sub = r / I_UP; r -= sub * I_UP; const int kb = r / 44, nb = r % 44, which = sub >> 1;
            const float* W = ((sub & 1) ? P.in[I_W3] : P.in[I_W1]) + (size_t)(l * 2 + which) * DM * DFF;
            const int c0 = nb * 64, dst = (c0 >> 7) * 256 + (sub & 1) * 128 + (c0 & 127);
            const float *g = nullptr, *b = nullptr;
            if (which == 1) { g = lng + (l * 3 + 1) * DM; b = lnb + (l * 3 + 1) * DM; } else if (l > 0) { g = lng + ((l - 1) * 3 + 2) * DM; b = lnb + ((l - 1) * 3 + 2) * DM; }
            conv_item(W, DFF, c0, 64, kb * 64, (bf16*)(ws + (which ? WS_W13B : WS_W13A)), DM, dst, g, b, 1.f, which ? cs13b : cs13a, which ? cb13b : cb13a, scr, lane);
            continue; }
        r -= 4 * I_UP;
        if (r < 2 * I_DN) { const int which = r / I_DN; r -= which * I_DN; const int kb = r / 16, nb = r % 16;
            conv_item(P.in[I_W2] + (size_t)(l * 2 + which) * DFF * DM, DM, nb * 64, 64, kb * 64, (bf16*)(ws + (which ? WS_W2B : WS_W2A)), DFF, nb * 64, nullptr, nullptr, 1.f, nullptr, nullptr, scr, lane);
            continue; }
        r -= 2 * I_DN;
        if (r < I_IN) { const int kb = r / 100, nb = r % 100, dst = nb * 64;
            int src = dst, nv = 64; float scale = 1.f;
            if (dst >= 4096 && dst < 6144) src = dst + 16; else if (dst == 6144) { src = 4096; nv = 16; } else if (dst > 6144) { src = 0; nv = 0; }
            if (dst >= ZQ && dst < ZK) scale = 0.08838834764831845f;
            conv_item(P.in[I_WIN] + (size_t)l * DM * INC, INC, src, nv, kb * 64, (bf16*)(ws + WS_WIN), DM, dst, lng + (l * 3) * DM, lnb + (l * 3) * DM, scale, csin, cbin, scr, lane);
            continue; }
        r -= I_IN;
        if (r < I_PA) { const int kb = r / 16, nb = r % 16;
            conv_item(P.in[I_WPA] + (size_t)l * 512 * DM, DM, nb * 64, 64, kb * 64, (bf16*)(ws + WS_WPA), 512, nb * 64, nullptr, nullptr, 1.f, nullptr, nullptr, scr, lane); continue; }
        r -= I_PA;
        { const int which = r / I_PB; r -= which * I_PB; const int kb = r / 16, nb = r % 16;
            conv_item((which ? P.in[I_WO] : P.in[I_WPB]) + (size_t)l * DM * DM, DM, nb * 64, 64, kb * 64, (bf16*)(ws + (which ? WS_WO : WS_WPB)), DM, nb * 64, nullptr, nullptr, 1.f, nullptr, nullptr, scr, lane); }
    }
    { const float* wsrc = P.in[I_GMWS] + (size_t)l * 65536; bf16* wd = (bf16*)(ws + WS_WSB);
      for (int i = blockIdx.x * 512 + tid; i < 65536; i += G * 512) { const int t = (i >> 7) & 127, s = i & 127; wd[i] = (bf16)(t >= s ? f2bf(wsrc[i]) : 0u); } }
    if (l == 0) {
        float* V = P.out; bf16* VB = (bf16*)(ws + WS_VB); int* st0 = (int*)(ws + WS_STATS);
        for (int m = gw; m < MT; m += NGW) {
            const float* xr = (m < MP) ? P.in[I_XP] + (size_t)m * DM : P.in[I_XS] + (size_t)(m - MP) * DM;
#pragma unroll
            for (int j = 0; j < 4; ++j) { const f32x4 v = *(const f32x4*)(xr + 4 * lane + 256 * j); if (G != 256) *(f32x4*)(V + (size_t)m * DM + 4 * lane + 256 * j) = v;
                u32x2 w; w.x = pk2(v[0], v[1]); w.y = pk2(v[2], v[3]); *(u32x2*)(VB + (size_t)m * DM + 4 * lane + 256 * j) = w; }
            if (lane == 0) { int idq = (int)((float)DM * (1.0f - LN_EPS) * FXQ); asm volatile("" : "+v"(idq));
                st0[2 * m] = 0; st0[2 * m + 1] = idq; }
        }
        if (blockIdx.x == 0) { float* o = (float*)(ws + WS_ONES); for (int i = tid; i < 2048; i += 512) o[i] = i < 1024 ? 1.f : 0.f; }
    }
}

__device__ __forceinline__ void prep_item(const Params& P, int l, int ci, LAS unsigned char* lds) {
    int tid = threadIdx.x; asm volatile("" : "+v"(tid));
    const int cp = tid & 255, rh = tid >> 8;
    LAS float* glr_s = (LAS float*)lds; LAS f32x2* tot_s = (LAS f32x2*)(glr_s + 1024);
    const size_t r0 = (size_t)ci * 64;
    const float* glr = (const float*)(P.ws + WS_GLR) + r0 * 16;
    if (tid < 256) ((LAS f32x4*)glr_s)[tid] = ((const f32x4*)glr)[tid];
    f32x2 w[16];
#pragma unroll
    for (int j = 0; j < 16; ++j) w[j] = *(const f32x2*)(P.in[I_WA2] + (size_t)(l * 16 + j) * 512 + 2 * cp);
    const f32x2 bias = *(const f32x2*)(P.in[I_BA] + l * 512 + 2 * cp);
    bf16* Z = (bf16*)(P.ws + WS_Z);
    unsigned* zq = (unsigned*)(Z + OZ_Q + (r0 + rh * 32) * 512 + 2 * cp); unsigned* zk = (unsigned*)(Z + OZ_K + (r0 + rh * 32) * 512 + 2 * cp);
    __syncthreads();
    f32x2 lg[32];
#pragma unroll
    for (int i = 0; i < 32; ++i) { const LAS f32x4* gr = (const LAS f32x4*)(glr_s + (rh * 32 + i) * 16); f32x2 x = bias;
#pragma unroll
        for (int q = 0; q < 4; ++q) { const f32x4 g4 = gr[q]; x += g4[0] * w[4 * q] + g4[1] * w[4 * q + 1] + g4[2] * w[4 * q + 2] + g4[3] * w[4 * q + 3]; }
        lg[i].x = (fminf(x.x, 0.f) - __logf(1.0f + __expf(-fabsf(x.x)))) * (1.0f / 16.0f);
        lg[i].y = (fminf(x.y, 0.f) - __logf(1.0f + __expf(-fabsf(x.y)))) * (1.0f / 16.0f); }
#pragma unroll
    for (int i = 1; i < 32; ++i) lg[i] += lg[i - 1];
    tot_s[rh * 256 + cp] = lg[31];
    __syncthreads();
    const f32x2 t0 = tot_s[cp], t1 = tot_s[256 + cp];
    const f32x2 off = rh ? t0 : (f32x2){0.f, 0.f}, total = t0 + t1;
#pragma unroll
    for (int bt = 0; bt < 4; ++bt) {
        unsigned qv[8], kv[8];
#pragma unroll
        for (int i = 0; i < 8; ++i) { qv[i] = zq[(size_t)(8 * bt + i) * 256]; kv[i] = zk[(size_t)(8 * bt + i) * 256]; }
#pragma unroll
        for (int i = 0; i < 8; ++i) { const f32x2 b = lg[8 * bt + i] + off;
            zq[(size_t)(8 * bt + i) * 256] = pk2(bflo(qv[i]) * __expf(b.x), bfhi(qv[i]) * __expf(b.y)); zk[(size_t)(8 * bt + i) * 256] = pk2(bflo(kv[i]) * __expf(-b.x), bfhi(kv[i]) * __expf(-b.y)); }
    }
    if (rh == 0) *(f32x2*)((float*)(P.ws + WS_DEC) + (size_t)ci * 512 + 2 * cp) = (f32x2){__expf(total.x), __expf(total.y)};
    __syncthreads();
}

typedef short s16x4 __attribute__((ext_vector_type(4)));
__device__ __forceinline__ bf16x8 tr_frag(const LAS bf16* tile, int pitch, int k0, int n0, int lane) {
    const int fq = lane >> 4, q = (lane & 15) >> 2, p = lane & 3;
    const LAS bf16* a = tile + (k0 + 8 * fq + q) * pitch + n0 + 4 * p;
    const s16x4 lo = __builtin_amdgcn_ds_read_tr16_b64_v4i16((LAS s16x4*)a), hi = __builtin_amdgcn_ds_read_tr16_b64_v4i16((LAS s16x4*)(a + 4 * pitch));
    return (bf16x8){lo.x, lo.y, lo.z, lo.w, hi.x, hi.y, hi.z, hi.w};
}

__device__ __forceinline__ void gmlp_item(const Params& P, int l, int it, LAS unsigned char* lds) {
    int tid = threadIdx.x; asm volatile("" : "+v"(tid));
    const int w = tid >> 6, lane = tid & 63, fr = lane & 15, fq = lane >> 4;
    const int cidx = it >> 2, g = it & 3;
    const bool samp = cidx >= 256; const int nrows = samp ? 64 : 128; const size_t r0 = samp ? (size_t)MP + (size_t)(cidx - 256) * 64 : (size_t)cidx * 128;
    constexpr int VP = 144;
    LAS bf16* vn_s = (LAS bf16*)lds;
    bf16* Z = (bf16*)(P.ws + WS_Z); const int* gst = (const int*)(P.ws + WS_GST) + (size_t)l * MT * 2;
    const float* gmg = P.in[I_GMG] + l * 512 + g * 128; const float* gmb = P.in[I_GMB] + l * 512 + g * 128;
    { const int seg = tid & 15; f32x4 g0 = *(const f32x4*)(gmg + seg * 8), g1 = *(const f32x4*)(gmg + seg * 8 + 4), b0 = *(const f32x4*)(gmb + seg * 8), b1 = *(const f32x4*)(gmb + seg * 8 + 4);
#pragma unroll
      for (int i = 0; i < 4; ++i) { const int row = (tid >> 4) + 32 * i; float vn[8];
        if (row < nrows) { const u32x4 raw = *(const u32x4*)(Z + OZ_V + (r0 + row) * 512 + g * 128 + seg * 8);
            const int2 s = *(const int2*)(gst + 2 * (r0 + row)); const float mu = (float)s.x * (FXS_INV / 512.0f), rstd = rsqrtf(fmaxf((float)s.y * (FXQ_INV / 512.0f) - mu * mu, 0.f) + LN_EPS);
            vn[0] = (bflo(raw.x) - mu) * rstd * g0[0] + b0[0]; vn[1] = (bfhi(raw.x) - mu) * rstd * g0[1] + b0[1]; vn[2] = (bflo(raw.y) - mu) * rstd * g0[2] + b0[2]; vn[3] = (bfhi(raw.y) - mu) * rstd * g0[3] + b0[3];
            vn[4] = (bflo(raw.z) - mu) * rstd * g1[0] + b1[0]; vn[5] = (bfhi(raw.z) - mu) * rstd * g1[1] + b1[1]; vn[6] = (bflo(raw.w) - mu) * rstd * g1[2] + b1[2]; vn[7] = (bfhi(raw.w) - mu) * rstd * g1[3] + b1[3];
            if (samp) { float* vo = P.out + OUT_VN + ((size_t)(l * DBATCH + (cidx - 256)) * DSEQ + row) * 512 + g * 128 + seg * 8;
                *(f32x4*)vo = (f32x4){vn[0], vn[1], vn[2], vn[3]}; *(f32x4*)(vo + 4) = (f32x4){vn[4], vn[5], vn[6], vn[7]}; }
        } else {
#pragma unroll
            for (int e = 0; e < 8; ++e) vn[e] = 0.f; }
        u32x4 pw; pw.x = pk2(vn[0], vn[1]); pw.y = pk2(vn[2], vn[3]); pw.z = pk2(vn[4], vn[5]); pw.w = pk2(vn[6], vn[7]);
        *(LAS u32x4*)(vn_s + row * VP + seg * 8) = pw;
      } }
    __syncthreads();
    if (16 * w < nrows) {
        const bf16* Wg = (const bf16*)(P.ws + WS_WSB) + (size_t)g * 16384 + (size_t)(16 * w + fr) * 128 + 8 * fq;
        const int nks = ((16 * w + 15) >> 5) + 1;
        bf16x8 fa[4];
#pragma unroll
        for (int ks = 0; ks < 4; ++ks) fa[ks] = (ks < nks) ? *(const bf16x8*)(Wg + 32 * ks) : (bf16x8){0, 0, 0, 0, 0, 0, 0, 0};
        const size_t rr = r0 + 16 * w + fr; const float bsv = P.in[I_GMBS][(size_t)(l * 4 + g) * 128 + 16 * w + fr];
#pragma unroll
        for (int dt = 0; dt < 8; ++dt) {
            f32x4 a = (f32x4){0.f, 0.f, 0.f, 0.f};
#pragma unroll
            for (int ks = 0; ks < 4; ++ks) if (ks < nks) { const bf16x8 fv = tr_frag(vn_s, VP, 32 * ks, 16 * dt, lane); a = __builtin_amdgcn_mfma_f32_16x16x32_bf16(fv, fa[ks], a, 0, 0, 0); }
            bf16* up = Z + OZ_U + rr * 512 + g * 128 + 16 * dt + 4 * fq; const u32x2 uu = *(const u32x2*)up;
            u32x2 o; o.x = pk2(bflo(uu.x) * (a[0] + bsv), bfhi(uu.x) * (a[1] + bsv)); o.y = pk2(bflo(uu.y) * (a[2] + bsv), bfhi(uu.y) * (a[3] + bsv));
            *(u32x2*)up = o;
        }
    }
    __syncthreads();
}

__device__ __forceinline__ void scan_item(const Params& P, int l, int sidx, int h, LAS unsigned char* lds) {
    int tid = threadIdx.x; asm volatile("" : "+v"(tid));
    const int w = tid >> 6, lane = tid & 63, fr = lane & 15, fq = lane >> 4;
    const bool samp = sidx >= NBATCH; const int nch = samp ? 1 : SEQ / 64; const int c0 = samp ? (MP / 64 + (sidx - NBATCH)) : sidx * (SEQ / 64);
    constexpr int QP = 136, KP = 144, VPT = 272, TP = 72;
    LAS bf16* qe_s = (LAS bf16*)lds;
    LAS bf16* ke_s = qe_s + 64 * QP;
    LAS bf16* v_s = ke_s + 64 * KP;
    LAS bf16* att_s = v_s + 64 * VPT;
    LAS float* dec_s = (LAS float*)(att_s + 64 * TP);
    LAS float* red_s = dec_s + 128;
    bf16* Z = (bf16*)(P.ws + WS_Z); const float* DEC = (const float*)(P.ws + WS_DEC);
    f32x4 S[2][8];
    if (samp) { const float* S0 = P.in[I_STATE] + ((size_t)(l * DBATCH + (sidx - NBATCH)) * 4 + h) * 32768;
        const float* sp = S0 + (size_t)(4 * fq) * 256 + 32 * w + fr;
#pragma unroll
        for (int kt = 0; kt < 8; ++kt) {
#pragma unroll
            for (int d = 0; d < 2; ++d)
#pragma unroll
                for (int j = 0; j < 4; ++j) S[d][kt][j] = sp[j * 256 + 16 * d];
            sp += 16 * 256; asm volatile("" : "+v"(sp) :: "memory"); }
    } else {
#pragma unroll
        for (int d = 0; d < 2; ++d)
#pragma unroll
            for (int kt = 0; kt < 8; ++kt) S[d][kt] = (f32x4){0.f, 0.f, 0.f, 0.f}; }
    const float* gnp = P.in[I_GNG] + l * 256 + 32 * w + 4 * fq;
    u32x4 qv[2], kv[2], vv[4]; float dcv = 0.f;
    const int seg16 = tid & 15, rowq = tid >> 4, seg32 = tid & 31, rowv = tid >> 5;
#define SCAN_LOAD_QK(ci) do { const size_t rb = (size_t)(ci) * 64; \
        _Pragma("unroll") for (int i = 0; i < 2; ++i) { const bf16* p = Z + (rb + rowq + 32 * i) * 512 + h * 128 + seg16 * 8; qv[i] = *(const u32x4*)(p + OZ_Q); kv[i] = *(const u32x4*)(p + OZ_K); } \
        if (tid < 128) dcv = DEC[((size_t)(ci) * 4 + h) * 128 + tid]; } while (0)
#define SCAN_LOAD_V(ci) do { const size_t rb = (size_t)(ci) * 64; \
        _Pragma("unroll") for (int i = 0; i < 4; ++i) vv[i] = *(const u32x4*)(Z + OZ_VG + (rb + rowv + 16 * i) * 1024 + h * 256 + seg32 * 8); } while (0)
    SCAN_LOAD_QK(c0); SCAN_LOAD_V(c0);
    for (int n = 0; n < nch; ++n) {
        const size_t r0 = (size_t)(c0 + n) * 64;
#pragma unroll
        for (int i = 0; i < 2; ++i) { const int row = rowq + 32 * i;
            *(LAS u32x4*)(qe_s + row * QP + seg16 * 8) = qv[i]; *(LAS u32x4*)(ke_s + row * KP + seg16 * 8) = kv[i]; }
#pragma unroll
        for (int i = 0; i < 4; ++i) *(LAS u32x4*)(v_s + (rowv + 16 * i) * VPT + seg32 * 8) = vv[i];
        if (tid < 128) dec_s[tid] = dcv;
        __syncthreads();
        if (n + 1 < nch) { SCAN_LOAD_QK(c0 + n + 1); SCAN_LOAD_V(c0 + n + 1); }
        __builtin_amdgcn_sched_barrier(0);
        { const int tt = w >> 1;
#pragma unroll
          for (int si = 0; si < 2; ++si) { const int st = 2 * (w & 1) + si; f32x4 a = (f32x4){0.f, 0.f, 0.f, 0.f};
            if (st <= tt) {
#pragma unroll
                for (int ks = 0; ks < 4; ++ks) { const bf16x8 fk = *(const LAS bf16x8*)(ke_s + (16 * st + fr) * KP + 32 * ks + 8 * fq), fqv = *(const LAS bf16x8*)(qe_s + (16 * tt + fr) * QP + 32 * ks + 8 * fq);
                    a = __builtin_amdgcn_mfma_f32_16x16x32_bf16(fk, fqv, a, 0, 0, 0); }
#pragma unroll
                for (int j = 0; j < 4; ++j) if (16 * st + 4 * fq + j > 16 * tt + fr) a[j] = 0.f; }
            u32x2 o; o.x = pk2(a[0], a[1]); o.y = pk2(a[2], a[3]); *(LAS u32x2*)(att_s + (16 * tt + fr) * TP + 16 * st + 4 * fq) = o; } }
        __syncthreads();
        __builtin_amdgcn_sched_barrier(0);
        f32x4 O[4][2];
#pragma unroll
        for (int tt = 0; tt < 4; ++tt)
#pragma unroll
            for (int d = 0; d < 2; ++d) O[tt][d] = (f32x4){0.f, 0.f, 0.f, 0.f};
#pragma unroll
        for (int ks = 0; ks < 2; ++ks) { bf16x8 fv[2];
#pragma unroll
            for (int d = 0; d < 2; ++d) fv[d] = tr_frag(v_s, VPT, 32 * ks, 32 * w + 16 * d, lane);
#pragma unroll
            for (int tt = 0; tt < 4; ++tt) { const bf16x8 fa = *(const LAS bf16x8*)(att_s + (16 * tt + fr) * TP + 32 * ks + 8 * fq);
#pragma unroll
                for (int d = 0; d < 2; ++d) O[tt][d] = __builtin_amdgcn_mfma_f32_16x16x32_bf16(fv[d], fa, O[tt][d], 0, 0, 0); } }
        __builtin_amdgcn_sched_barrier(0);
#pragma unroll
        for (int ks = 0; ks < 4; ++ks) { bf16x8 fs[2];
#pragma unroll
            for (int d = 0; d < 2; ++d) { const f32x4 s0 = S[d][2 * ks], s1 = S[d][2 * ks + 1]; u32x4 pkd; pkd.x = pk2(s0[0], s0[1]); pkd.y = pk2(s0[2], s0[3]); pkd.z = pk2(s1[0], s1[1]); pkd.w = pk2(s1[2], s1[3]); fs[d] = __builtin_bit_cast(bf16x8, pkd); }
#pragma unroll
            for (int tt = 0; tt < 4; ++tt) { const LAS bf16* qp = qe_s + (16 * tt + fr) * QP + 32 * ks + 4 * fq; const u32x2 lo = *(const LAS u32x2*)qp, hi = *(const LAS u32x2*)(qp + 16);
                const bf16x8 fqp = __builtin_bit_cast(bf16x8, ((u32x4){lo.x, lo.y, hi.x, hi.y}));
#pragma unroll
                for (int d = 0; d < 2; ++d) O[tt][d] = __builtin_amdgcn_mfma_f32_16x16x32_bf16(fs[d], fqp, O[tt][d], 0, 0, 0); } }
        __builtin_amdgcn_sched_barrier(0);
        u32x2 ggv[4][2];
#pragma unroll
        for (int tt = 0; tt < 4; ++tt)
#pragma unroll
            for (int d = 0; d < 2; ++d) ggv[tt][d] = *(const u32x2*)(Z + OZ_GG + (r0 + 16 * tt + fr) * 1024 + h * 256 + 32 * w + 4 * fq + 16 * d);
        __builtin_amdgcn_sched_barrier(0);
#pragma unroll
        for (int ks = 0; ks < 2; ++ks) { bf16x8 fv[2];
#pragma unroll
            for (int d = 0; d < 2; ++d) fv[d] = tr_frag(v_s, VPT, 32 * ks, 32 * w + 16 * d, lane);
#pragma unroll
            for (int kt = 0; kt < 8; ++kt) { const bf16x8 fk = tr_frag(ke_s, KP, 32 * ks, 16 * kt, lane);
#pragma unroll
                for (int d = 0; d < 2; ++d) S[d][kt] = __builtin_amdgcn_mfma_f32_16x16x32_bf16(fk, fv[d], S[d][kt], 0, 0, 0); } }
#pragma unroll
        for (int kt = 0; kt < 8; ++kt) { const f32x4 dc = *(const LAS f32x4*)(dec_s + 16 * kt + 4 * fq);
#pragma unroll
            for (int d = 0; d < 2; ++d) S[d][kt] = S[d][kt] * dc; }
        __builtin_amdgcn_sched_barrier(0);
#pragma unroll
        for (int tt = 0; tt < 4; ++tt) { float ss = 0.f;
#pragma unroll
            for (int d = 0; d < 2; ++d) ss += (O[tt][d][0] * O[tt][d][0] + O[tt][d][1] * O[tt][d][1]) + (O[tt][d][2] * O[tt][d][2] + O[tt][d][3] * O[tt][d][3]);
            ss += __shfl_xor(ss, 16); ss += __shfl_xor(ss, 32);
            if (fq == 0) red_s[w * 64 + 16 * tt + fr] = ss; }
        __syncthreads();
#pragma unroll
        for (int tt = 0; tt < 4; ++tt) { float tot = 0.f;
#pragma unroll
            for (int q = 0; q < 8; ++q) tot += red_s[q * 64 + 16 * tt + fr];
            const float rstd = rsqrtf(tot * (1.0f / 256.0f) + LN_EPS);
            bf16* zr = Z + (r0 + 16 * tt + fr) * 1024 + h * 256 + 32 * w + 4 * fq;
#pragma unroll
            for (int d = 0; d < 2; ++d) { const u32x2 gg = ggv[tt][d]; const f32x4 o = O[tt][d] * rstd * *(const f32x4*)(gnp + 16 * d);
                u32x2 ow; ow.x = pk2(o[0] * bflo(gg.x), o[1] * bfhi(gg.x)); ow.y = pk2(o[2] * bflo(gg.y), o[3] * bfhi(gg.y));
                *(u32x2*)(zr + OZ_VG + 16 * d) = ow; } }
    }
#undef SCAN_LOAD_QK
#undef SCAN_LOAD_V
    float* So = samp ? P.out + OUT_SS + ((size_t)(l * DBATCH + (sidx - NBATCH)) * 4 + h) * 32768 : P.out + OUT_SP + ((size_t)(l * NBATCH + sidx) * 4 + h) * 32768;
    So += (size_t)(4 * fq) * 256 + 32 * w + fr;
#pragma unroll
    for (int kt = 0; kt < 8; ++kt) {
#pragma unroll
        for (int d = 0; d < 2; ++d)
#pragma unroll
            for (int j = 0; j < 4; ++j) So[j * 256 + 16 * d] = S[d][kt][j];
        So += 16 * 256; asm volatile("" : "+v"(So) :: "memory"); }
    __syncthreads();
}
#define XB_TMO      128
#define XB_XCNT(j)  (256  + 64 * (j))
#define XB_XSUB(j)  (1280 + 64 * (j))
#define XB_XGEN(j)  (2304 + 64 * (j))
#define XB_TOP      3328
#define XB_TOPGEN   3392
#define XCD_BAR_WORDS 3456
#define XB_SPIN_CAP (1u << 18)

__device__ __forceinline__ unsigned xb_ld(unsigned* p)              { return __hip_atomic_load(p, __ATOMIC_RELAXED, __HIP_MEMORY_SCOPE_AGENT); }
__device__ __forceinline__ unsigned xb_add(unsigned* p, unsigned v) { return __hip_atomic_fetch_add(p, v, __ATOMIC_RELAXED, __HIP_MEMORY_SCOPE_AGENT); }
__device__ __forceinline__ unsigned xb_xcc_id() { return (unsigned)__builtin_amdgcn_s_getreg((3 << 11) | 20) & 0xFu; }
#define XB_SPIN(cond, bar) do { unsigned _sp = 0; while (cond) { __builtin_amdgcn_s_sleep(1); \
    if ((++_sp & 255u) == 0u) { if (xb_ld(&(bar)[XB_TMO])) break; if (_sp > XB_SPIN_CAP) { atomicAdd(&(bar)[XB_TMO], 1u); break; } } } } while (0)

struct XcdBarrier {
    unsigned* bar; unsigned x;
    volatile LAS unsigned* st;
};

__device__ __forceinline__ XcdBarrier xcd_barrier_post(unsigned* bar, volatile LAS unsigned* st) {
    XcdBarrier b; b.bar = bar; b.x = xb_xcc_id(); b.st = st;
    if (threadIdx.x == 0) (void)xb_add(&bar[XB_XCNT(b.x)], 1u);
    return b;
}
__device__ __forceinline__ void xcd_barrier_complete(unsigned* bar, unsigned x, unsigned& nloc, unsigned& nx) {
    const unsigned G = gridDim.x * gridDim.y * gridDim.z;
    unsigned sum, cnt, mine, sp = 0u;
    for (;;) {
        sum = 0u; cnt = 0u; mine = 0u;
#pragma unroll
        for (unsigned j = 0; j < 16; ++j) { const unsigned c = xb_ld(&bar[XB_XCNT(j)]); sum += c; cnt += (c > 0u) ? 1u : 0u; mine = (j == x) ? c : mine; }
        if (sum == G) break;
        __builtin_amdgcn_s_sleep(1);
        if ((++sp & 255u) == 0u) { if (xb_ld(&bar[XB_TMO])) break; if (sp > XB_SPIN_CAP) { atomicAdd(&bar[XB_TMO], 1u); break; } }
    }
    nloc = mine > 0u ? mine : 1u; nx = cnt > 0u ? cnt : 1u;
}

__device__ __forceinline__ void xcd_barrier(const XcdBarrier& b) {
    asm volatile("s_waitcnt vmcnt(0)" ::: "memory");
    __syncthreads();
    if (threadIdx.x == 0) {
        unsigned* bar = b.bar;
        __builtin_amdgcn_s_waitcnt(0);
        unsigned nloc = b.st[0], nx = b.st[1];
        if (nloc == 0u) { xcd_barrier_complete(bar, b.x, nloc, nx); b.st[0] = nloc; b.st[1] = nx; }
        const unsigned old = xb_add(&bar[XB_XSUB(b.x)], 1u);
        const unsigned gen = old / nloc;
        if (old + 1u == (gen + 1u) * nloc) {
            __builtin_amdgcn_fence(__ATOMIC_RELEASE, "agent");
            asm volatile("s_waitcnt vmcnt(0)" ::: "memory");
            const unsigned og = xb_add(&bar[XB_TOP], 1u);
            const unsigned tg = og / nx;
            if (og + 1u == (tg + 1u) * nx) xb_add(&bar[XB_TOPGEN], 1u);
            else XB_SPIN(xb_ld(&bar[XB_TOPGEN]) == tg, bar);
            __builtin_amdgcn_fence(__ATOMIC_ACQUIRE, "agent");
            xb_add(&bar[XB_XGEN(b.x)], 1u);
            asm volatile("s_waitcnt vmcnt(0)" ::: "memory");
        } else {
            XB_SPIN(xb_ld(&bar[XB_XGEN(b.x)]) == gen, bar);
            __builtin_amdgcn_fence(__ATOMIC_ACQUIRE, "agent");
            asm volatile("s_waitcnt vmcnt(0)" ::: "memory");
        }
    }
    __syncthreads();
}

#ifndef GEMSEL
#define GEMSEL 255
#endif
#ifndef PHM
#define PHM 31
#endif
#if PHM & 8
#define SCAN_CALL scan_item
#else
#define SCAN_CALL(...) do {} while (0)
#endif
#if PHM & 16
#define GMLP_CALL gmlp_item
#else
#define GMLP_CALL(...) do {} while (0)
#endif
template <class Epi> __device__ __forceinline__ void run_gemm(LAS unsigned char* lds, const bf16* A, int lda, const bf16* Bt, int N, int K, const Epi& E, int M = MT, int G = -1, int c = -1) {
    if (G < 0) { G = (int)gridDim.x; c = (int)blockIdx.x; }
    pg8::Gemm g{A, Bt, lda, M, N, K}; pg8::StaticOrder S; S.init(M, N, G, c);
#if PHM & 2
    pg8::gemm_phase<Epi, pg8::StaticOrder, true, true>((PG8_LAS unsigned char*)lds, g, S, E);
#endif
}

struct WinOrder : pg8::StaticOrder {
    const unsigned* cntB;
    __device__ bool next(int i, pg8::Unit& u) const {
        const int skip = c < 8 ? 4 : c < 44 ? 1 : 0; const int ii = i + skip;
        int L;
        if (ii < 12) L = ii * 256 + c;
        else if (ii == 12) { if (c < 178) L = 12 * 256 + c; else { const int o = c - 178; if (o >= 68) return false; L = o < 32 ? (o & 3) * 256 + (o >> 2) : (o - 32 + 8); } }
        else return false;
        if (L >= nwg) return false;
        int wgid = L; { const int q = nwg / pg8::NXCD, r = nwg % pg8::NXCD, xcd = wgid % pg8::NXCD, off = wgid / pg8::NXCD; wgid = (xcd < r ? xcd * (q + 1) : r * (q + 1) + (xcd - r) * q) + off; }
        const int nig = pg8::WGM * nN, gid = wgid / nig, fm = gid * pg8::WGM, gsz = (nM - fm) < pg8::WGM ? (nM - fm) : pg8::WGM;
        u.pm = fm + ((wgid % nig) % gsz); u.pn = (wgid % nig) / gsz; return true;
    }
    __device__ __forceinline__ void a_ready(const pg8::Unit& u) const {
        if (u.pm >= MP / 256) {
            if (threadIdx.x < 64) { unsigned sp = 0;
                while ((unsigned)__builtin_amdgcn_readfirstlane(__hip_atomic_load(cntB, __ATOMIC_RELAXED, __HIP_MEMORY_SCOPE_AGENT)) < 8u) { __builtin_amdgcn_s_sleep(2); if (++sp > (1u << 22)) break; }
                __builtin_amdgcn_fence(__ATOMIC_ACQUIRE, "agent"); asm volatile("s_waitcnt vmcnt(0)" ::: "memory"); }
            asm volatile("" ::: "memory"); __builtin_amdgcn_s_barrier(); asm volatile("" ::: "memory");
        }
    }
};
__device__ __forceinline__ void wg_publish(unsigned* cnt) {
    asm volatile("s_waitcnt vmcnt(0) lgkmcnt(0)" ::: "memory"); __syncthreads();
    if (threadIdx.x == 0) { __builtin_amdgcn_fence(__ATOMIC_RELEASE, "agent"); asm volatile("s_waitcnt vmcnt(0)" ::: "memory"); (void)__hip_atomic_fetch_add(cnt, 1u, __ATOMIC_RELAXED, __HIP_MEMORY_SCOPE_AGENT); }
}
__device__ __forceinline__ void wg_wait(const unsigned* cnt, unsigned target) {
    if (threadIdx.x == 0) { unsigned sp = 0; while (__hip_atomic_load(cnt, __ATOMIC_RELAXED, __HIP_MEMORY_SCOPE_AGENT) < target) { __builtin_amdgcn_s_sleep(2); if (++sp > (1u << 22)) break; }
        __builtin_amdgcn_fence(__ATOMIC_ACQUIRE, "agent"); asm volatile("s_waitcnt vmcnt(0)" ::: "memory"); }
    __syncthreads();
}
__device__ __forceinline__ void sub_barrier(unsigned* cnt, unsigned target) {
    asm volatile("s_waitcnt vmcnt(0) lgkmcnt(0)" ::: "memory"); __syncthreads();
    if (threadIdx.x == 0) {
        __builtin_amdgcn_fence(__ATOMIC_RELEASE, "agent"); asm volatile("s_waitcnt vmcnt(0)" ::: "memory");
        (void)__hip_atomic_fetch_add(cnt, 1u, __ATOMIC_RELAXED, __HIP_MEMORY_SCOPE_AGENT);
        unsigned sp = 0; while (__hip_atomic_load(cnt, __ATOMIC_RELAXED, __HIP_MEMORY_SCOPE_AGENT) < target) { __builtin_amdgcn_s_sleep(1); if (++sp > (1u << 22)) break; }
        __builtin_amdgcn_fence(__ATOMIC_ACQUIRE, "agent"); asm volatile("s_waitcnt vmcnt(0)" ::: "memory");
    }
    __syncthreads();
}
constexpr int PTAB_OFF = 139264 + 64;
__device__ __forceinline__ const float* ptab_ld(LAS unsigned char* lds, int i) {
    unsigned base = PTAB_OFF; asm volatile("" : "+v"(base));
    const unsigned long long v = ((volatile LAS unsigned long long*)(lds + base))[i];
    const unsigned lo = __builtin_amdgcn_readfirstlane((unsigned)v), hi = __builtin_amdgcn_readfirstlane((unsigned)(v >> 32));
    return (const float*)(((unsigned long long)hi << 32) | lo);
}
__device__ __forceinline__ Params ptab_params(LAS unsigned char* lds) {
    Params Q;
    unsigned base = PTAB_OFF; asm volatile("" : "+v"(base));
    volatile LAS unsigned long long* tab = (volatile LAS unsigned long long*)(lds + base);
#pragma unroll
    for (int i = 0; i < 21; ++i) { const unsigned long long v = tab[i];
        const unsigned lo = __builtin_amdgcn_readfirstlane((unsigned)v), hi = __builtin_amdgcn_readfirstlane((unsigned)(v >> 32));
        const float* p = (const float*)(((unsigned long long)hi << 32) | lo);
        if (i < 19) Q.in[i] = p; else if (i == 19) Q.out = (float*)p; else Q.ws = (unsigned char*)p; }
    return Q;
}
#ifndef PROBE_MASK
#define PROBE_MASK 0
#endif
#ifndef PROBE_K
#define PROBE_K 1
#endif
__global__ void __launch_bounds__(512, 2) fwd_megakernel(Params P) {
    extern __shared__ __attribute__((aligned(16))) unsigned char lds_raw[];
    LAS unsigned char* lds = (LAS unsigned char*)lds_raw;
    cg::grid_group grid = cg::this_grid();
    volatile LAS unsigned* bar_st = (volatile LAS unsigned*)(lds + 139264);
    if (threadIdx.x < 4) bar_st[threadIdx.x] = 0u;
    if (threadIdx.x < 19) ((volatile LAS unsigned long long*)(lds + PTAB_OFF))[threadIdx.x] = (unsigned long long)P.in[threadIdx.x];
    if (threadIdx.x == 19) ((volatile LAS unsigned long long*)(lds + PTAB_OFF))[19] = (unsigned long long)P.out;
    if (threadIdx.x == 20) ((volatile LAS unsigned long long*)(lds + PTAB_OFF))[20] = (unsigned long long)P.ws;
    __syncthreads();
    { const XcdBarrier xb0 = xcd_barrier_post((unsigned*)(P.ws + WS_BAR), bar_st); if (threadIdx.x == 0) bar_st[2] = xb0.x; }
#define GRID_SYNC() do { XcdBarrier xb_; xb_.bar = (unsigned*)(ptab_ld(lds, 20)) + WS_BAR / 4; xb_.st = bar_st; xb_.x = (unsigned)__builtin_amdgcn_readfirstlane((int)bar_st[2]); xcd_barrier(xb_); } while (0)
#define GRID_SYNC_CG() do { asm volatile("s_waitcnt vmcnt(0) lgkmcnt(0)" ::: "memory"); grid.sync(); __builtin_amdgcn_fence(__ATOMIC_ACQUIRE, "agent"); asm volatile("s_waitcnt vmcnt(0)" ::: "memory"); } while (0)
    unsigned long long tprev = 0;
    if (PROBE_MASK) tprev = __builtin_amdgcn_s_memrealtime();
#define GSYNC(grp) do { GRID_SYNC(); if (PROBE_MASK) { if (PROBE_MASK & (grp)) { const unsigned long long now = __builtin_amdgcn_s_memrealtime(), until = now + (now - tprev) * PROBE_K; \
        while (__builtin_amdgcn_s_memrealtime() < until) __builtin_amdgcn_s_sleep(8); } tprev = __builtin_amdgcn_s_memrealtime(); } } while (0)
#define PHASE_PTRS() const Params Q = ptab_params(lds); unsigned char* ws = Q.ws; float* V = Q.out; bf16* VB = (bf16*)(ws + WS_VB); bf16* Z = (bf16*)(ws + WS_Z); bf16* H = Z; \
        int* stats = (int*)(ws + WS_STATS); const float* lng = Q.in[I_LNG]; const float* lnb = Q.in[I_LNB]; const float* ones = (const float*)(ws + WS_ONES); const float* zeros = ones + 1024; \
        int* cscb = (int*)(ws + WS_CSCB) + (size_t)l * CSCB_L; int *cs13a = cscb, *cb13a = cscb + NUP, *csin = cscb + 2 * NUP, *cbin = csin + NIN, *cs13b = cbin + NIN, *cb13b = cs13b + NUP; \
        int* st0 = stats + (size_t)(3 * l) * MT * 2; int* st1 = st0 + (size_t)MT * 2; int* st2 = st1 + (size_t)MT * 2; int* st3 = st2 + (size_t)MT * 2; \
        const float* g_prev = l ? lng + ((l - 1) * 3 + 2) * DM : ones; const float* b_prev = l ? lnb + ((l - 1) * 3 + 2) * DM : zeros; \
        (void)V; (void)VB; (void)Z; (void)H; (void)cs13a; (void)cb13a; (void)csin; (void)cbin; (void)cs13b; (void)cb13b; (void)st0; (void)st1; (void)st2; (void)st3; (void)g_prev; (void)b_prev
    for (int l = 0; l < DEPTH; ++l) {
#if PHM & 1
        { PHASE_PTRS(); convert_phase(Q, l, lds); }
#endif
        if (l == 0) { GRID_SYNC_CG(); if (PROBE_MASK) { if (PROBE_MASK & 128) { const unsigned long long now = __builtin_amdgcn_s_memrealtime(), until = now + (now - tprev) * PROBE_K; while (__builtin_amdgcn_s_memrealtime() < until) __builtin_amdgcn_s_sleep(8); } tprev = __builtin_amdgcn_s_memrealtime(); } } else GSYNC(1);
#ifdef PROBE_EXTRA_SYNCS
        for (int xs = 0; xs < PROBE_EXTRA_SYNCS; ++xs) GRID_SYNC();
#endif
        { PHASE_PTRS(); EpiUp E{H, st0, cs13a, cb13a}; if (GEMSEL & 1) run_gemm(lds, VB, DM, (const bf16*)(ws + WS_W13A), NUP, DM, E, gridDim.x == 256 ? MP : MT); }
        GSYNC(2);
        { PHASE_PTRS(); EpiRes E{(l == 0 && gridDim.x == 256) ? Q.in[I_XP] : V, V, VB, st0, g_prev, b_prev, st1, 0.5f}; if (GEMSEL & 2) run_gemm(lds, H, DFF, (const bf16*)(ws + WS_W2A), DM, DFF, E, gridDim.x == 256 ? MP : MT); }
        GSYNC(4);
        { PHASE_PTRS(); EpiZ E{Z, st1, csin, cbin, (int*)(ws + WS_GST) + (size_t)l * MT * 2, (float*)(ws + WS_GLR)};
          if (gridDim.x == 256) {
              unsigned* cntA = (unsigned*)(ws + WS_SUB) + (DEPTH + 2 * l) * 64; unsigned* cntB = cntA + 64; int bx = blockIdx.x; asm volatile("" : "+s"(bx));
              bf16* HS = (bf16*)(ws + WS_HS);
              if (bx < 44) { EpiUp EU{HS, st0 + 2 * MP, cs13a, cb13a}; run_gemm(lds, VB + (size_t)MP * DM, DM, (const bf16*)(ws + WS_W13A), NUP, DM, EU, MS, 44, bx); wg_publish(cntA); }
              if (bx < 8) { wg_wait(cntA, 44u);
                  EpiRes ER{l == 0 ? Q.in[I_XS] : V + (size_t)MP * DM, V + (size_t)MP * DM, VB + (size_t)MP * DM, st0 + 2 * MP, g_prev, b_prev, st1 + 2 * MP, 0.5f}; run_gemm(lds, HS, DFF, (const bf16*)(ws + WS_W2A), DM, DFF, ER, MS, 8, bx); wg_publish(cntB); }
              __syncthreads();
              pg8::Gemm g{VB, (const bf16*)(ws + WS_WIN), DM, MT, NIN, DM}; WinOrder S; S.init(MT, NIN, 256, bx); S.cntB = cntB;
              pg8::gemm_phase<EpiZ, WinOrder, true, true>((PG8_LAS unsigned char*)lds, g, S, E);
          } else if (GEMSEL & 4) run_gemm(lds, VB, DM, (const bf16*)(ws + WS_WIN), NIN, DM, E); }
        GSYNC(8);
#if PHM & 4
        { PHASE_PTRS(); for (int it = blockIdx.x; it < NCHUNK; it += gridDim.x) prep_item(Q, l, it, lds);
          if (blockIdx.x >= 224) GMLP_CALL(Q, l, 1024 + ((int)blockIdx.x - 224), lds); }
#endif
        GSYNC(16);
        { PHASE_PTRS(); const int G = gridDim.x, bx = blockIdx.x; const int nscan = (NBATCH + DBATCH) * 4;
          if (G == 256) {
            if (bx < nscan) SCAN_CALL(Q, l, bx >> 2, bx & 3, lds);
            else if (bx < 128) { if (bx < 104) { EpiGate<false> E{Z + (size_t)MP * 1024}; run_gemm(lds, Z + OZ_U + (size_t)MP * 512, 512, (const bf16*)(ws + WS_WPA), DM, 512, E, MS, 8, bx - 96); } }
            else {
                const int pj = bx - 128;
                for (int k = 0; k < 8; ++k) GMLP_CALL(Q, l, 8 * pj + k, lds);
                asm volatile("s_waitcnt vmcnt(0) lgkmcnt(0)" ::: "memory"); __syncthreads();
                __builtin_amdgcn_fence(__ATOMIC_ACQUIRE, "agent"); asm volatile("s_waitcnt vmcnt(0)" ::: "memory");
                { EpiGate<false> E{Z + (size_t)pj * 256 * 1024}; run_gemm(lds, Z + OZ_U + (size_t)pj * 256 * 512, 512, (const bf16*)(ws + WS_WPA), DM, 512, E, 256, 1, 0); }
            }
            if (bx >= 64 && bx < 128) {
                unsigned* hc = (unsigned*)(ws + WS_SUB) + (3 * DEPTH + 4 * l) * 64; const int c = bx - 64;
                bf16* HS = (bf16*)(ws + WS_HS); bf16* Zs = Z + (size_t)MP * 1024;
                if (bx < 104) wg_publish(hc);
                if (c < 8) { wg_wait(hc, 40u);
                { EpiGate<true> E{Zs}; run_gemm(lds, Zs + OZ_VG, DM, (const bf16*)(ws + WS_WPB), DM, DM, E, MS, 64, c); }
                wg_publish(hc + 64); wg_wait(hc + 64, 8u);
                { EpiRes E{V + (size_t)MP * DM, V + (size_t)MP * DM, VB + (size_t)MP * DM, st1 + 2 * MP, lng + (l * 3) * DM, lnb + (l * 3) * DM, st2 + 2 * MP, 1.0f}; run_gemm(lds, Zs + OZ_GB, DM, (const bf16*)(ws + WS_WO), DM, DM, E, MS, 64, c); }
                wg_publish(hc + 128); }
                if (c < 44) { wg_wait(hc + 128, 8u);
                { EpiUp E{HS, st2 + 2 * MP, cs13b, cb13b}; run_gemm(lds, VB + (size_t)MP * DM, DM, (const bf16*)(ws + WS_W13B), NUP, DM, E, MS, 64, c); }
                wg_publish(hc + 192); }
                if (c < 8) { wg_wait(hc + 192, 44u);
                { EpiRes E{V + (size_t)MP * DM, V + (size_t)MP * DM, VB + (size_t)MP * DM, st2 + 2 * MP, lng + (l * 3 + 1) * DM, lnb + (l * 3 + 1) * DM, st3 + 2 * MP, 0.5f}; run_gemm(lds, HS, DFF, (const bf16*)(ws + WS_W2B), DM, DFF, E, MS, 64, c); } }
            }
          } else { const int ns = G >= 2 * nscan ? nscan : G;
            if (G >= 2 * nscan) { if (bx < nscan) SCAN_CALL(Q, l, bx >> 2, bx & 3, lds); else for (int it = bx - nscan; it < (256 + DBATCH) * 4; it += G - nscan) GMLP_CALL(Q, l, it, lds); }
            else { for (int it = bx; it < nscan; it += ns) SCAN_CALL(Q, l, it >> 2, it & 3, lds); for (int it = bx; it < (256 + DBATCH) * 4; it += G) GMLP_CALL(Q, l, it, lds); } } }
        GSYNC(32);
        if (gridDim.x != 256) { { PHASE_PTRS(); EpiGate<false> E{Z}; if (GEMSEL & 8) run_gemm(lds, Z + OZ_U, 512, (const bf16*)(ws + WS_WPA), DM, 512, E, MT); }
        GSYNC(64); }
        { PHASE_PTRS(); EpiGate<true> E{Z}; if (GEMSEL & 16) run_gemm(lds, Z + OZ_VG, DM, (const bf16*)(ws + WS_WPB), DM, DM, E, gridDim.x == 256 ? MP : MT); }
        GSYNC(64);
        { PHASE_PTRS(); EpiRes E{V, V, VB, st1, lng + (l * 3) * DM, lnb + (l * 3) * DM, st2, 1.0f}; if (GEMSEL & 32) run_gemm(lds, Z + OZ_GB, DM, (const bf16*)(ws + WS_WO), DM, DM, E, gridDim.x == 256 ? MP : MT); }
        GSYNC(64);
        { PHASE_PTRS(); EpiUp E{H, st2, cs13b, cb13b}; if (GEMSEL & 64) run_gemm(lds, VB, DM, (const bf16*)(ws + WS_W13B), NUP, DM, E, gridDim.x == 256 ? MP : MT); }
        GSYNC(2);
        { PHASE_PTRS(); EpiRes E{V, V, VB, st2, lng + (l * 3 + 1) * DM, lnb + (l * 3 + 1) * DM, st3, 0.5f}; if (GEMSEL & 128) run_gemm(lds, H, DFF, (const bf16*)(ws + WS_W2B), DM, DFF, E, gridDim.x == 256 ? MP : MT); }
        GSYNC(4);
    }
    { const int l = DEPTH - 1; PHASE_PTRS(); const int tid = threadIdx.x, G = gridDim.x, bx = blockIdx.x;
      const int* st = stats + (size_t)12 * MT * 2; const float* g = lng + 11 * DM; const float* b = lnb + 11 * DM; const int lane = tid & 63, wave = tid >> 6;
      f32x4 gv[4], bv[4];
#pragma unroll
      for (int j = 0; j < 4; ++j) { gv[j] = *(const f32x4*)(g + 4 * lane + 256 * j); bv[j] = *(const f32x4*)(b + 4 * lane + 256 * j); }
      for (int m = bx * 8 + wave; m < MT; m += G * 8) { float mu, rstd; row_stat(st, m, mu, rstd); float* vr = V + (size_t)m * DM + 4 * lane;
#pragma unroll
          for (int j = 0; j < 4; ++j) { const f32x4 v = __builtin_nontemporal_load((const f32x4*)(vr + 256 * j)); __builtin_nontemporal_store((v - mu) * rstd * gv[j] + bv[j], (f32x4*)(vr + 256 * j)); } } }
    if (PROBE_MASK & 256) GSYNC(256);
}

extern "C" void kernel_launch(void* const* d_in, const int* in_sizes, int n_in, void* d_out, int out_size, void* d_ws, size_t ws_size, hipStream_t stream) {
    static int grid = 0;
    if (grid == 0) {
        if (n_in != 19 || (size_t)out_size != OUT_END || ws_size < WS_END) { fprintf(stderr, "kernel_launch: unexpected shapes: n_in %d out %d ws %zu (need %zu)\n", n_in, out_size, ws_size, (size_t)WS_END); grid = -1; return; }
        int dev = 0, cus = 0, per_cu = 0;
        if (hipGetDevice(&dev) != hipSuccess || hipDeviceGetAttribute(&cus, hipDeviceAttributeMultiprocessorCount, dev) != hipSuccess) { grid = -1; return; }
        if (hipFuncSetAttribute((const void*)fwd_megakernel, hipFuncAttributeMaxDynamicSharedMemorySize, LDS_BYTES) != hipSuccess) { fprintf(stderr, "kernel_launch: hipFuncSetAttribute failed\n"); grid = -1; return; }
        if (hipOccupancyMaxActiveBlocksPerMultiprocessor(&per_cu, (const void*)fwd_megakernel, 512, LDS_BYTES) != hipSuccess || per_cu < 1) { fprintf(stderr, "kernel_launch: occupancy query gives %d\n", per_cu); per_cu = 1; }
        (void)hipGetLastError();
        grid = cus;
    }
    if (grid < 0) return;
    (void)hipMemsetAsync(d_ws, 0, ZERO_BYTES, stream);
    Params p{};
    for (int i = 0; i < 19; ++i) p.in[i] = (const float*)d_in[i];
    p.out = (float*)d_out; p.ws = (unsigned char*)d_ws;
    void* args[] = {&p};
    hipError_t e = hipLaunchCooperativeKernel((const void*)fwd_megakernel, dim3(grid), dim3(512), args, LDS_BYTES, stream);
    if (e != hipSuccess) fprintf(stderr, "cooperative launch failed: %s (grid %d)\n", hipGetErrorString(e), grid);
}
```
